# Optimizing an MI355X kernel written in HIP

```python
import math
import jax, jax.numpy as jnp
from jax import lax
import numpy as np

D_MODEL = 1024
BATCH = 2
SEQ = 16384
DEPTH = 1
DEC_BATCH = 32
DEC_SEQ = 2048
PAST_LEN = 128

N_MEM = 256
S5_WIDTH = D_MODEL // 2
S5_GROUP = 16
S5_GROUPS = S5_WIDTH // S5_GROUP
S5_STATE = 64
RET_WIDTH = D_MODEL - S5_WIDTH
RET_HEADS = 4
RET_HEAD_DIM = RET_WIDTH // RET_HEADS
RET_CHUNK = 128
ROPE_BASE = 10000.0
XATTN_HEADS = 4
XATTN_HEAD_DIM = D_MODEL // XATTN_HEADS
D_FF = -(-8 * D_MODEL // (3 * 256)) * 256
IN_WIDTH = S5_WIDTH + 4 * RET_WIDTH
EPS = 1e-6
DT_MIN = 1e-3
DT_MAX = 1e-1

kernel_name = 'hybrid_s5_retention_encoder'


def rmsnorm(x, w):
    xf = x.astype(jnp.float32)
    y = xf * lax.rsqrt(jnp.mean(xf * xf, axis=-1, keepdims=True) + EPS)
    return (y * w.astype(jnp.float32)).astype(x.dtype)


def s5_zoh(lam_re, lam_im, log_dt, b_re, b_im):
    dt = jnp.exp(log_dt)[..., None]
    mag = jnp.exp(lam_re * dt)
    ab_re = mag * jnp.cos(lam_im * dt)
    ab_im = mag * jnp.sin(lam_im * dt)
    den = lam_re * lam_re + lam_im * lam_im
    nr = ab_re - 1.0
    ni = ab_im
    f_re = (nr * lam_re + ni * lam_im) / den
    f_im = (ni * lam_re - nr * lam_im) / den
    bb_re = f_re[..., None] * b_re - f_im[..., None] * b_im
    bb_im = f_re[..., None] * b_im + f_im[..., None] * b_re
    return ab_re, ab_im, bb_re, bb_im


def _complex_linear_op(e, l):
    a_er, a_ei, b_er, b_ei = e
    a_lr, a_li, b_lr, b_li = l
    return (a_lr * a_er - a_li * a_ei,
            a_lr * a_ei + a_li * a_er,
            a_lr * b_er - a_li * b_ei + b_lr,
            a_lr * b_ei + a_li * b_er + b_li)


def s5_mixer(u, lam_re, lam_im, log_dt, b_re, b_im, c_re, c_im, d_skip, w_glu, b_glu):
    f32 = jnp.float32
    bsz, L, _ = u.shape
    uf = u.astype(f32).reshape(bsz, L, S5_GROUPS, S5_GROUP)
    ab_re, ab_im, bb_re, bb_im = s5_zoh(lam_re.astype(f32), lam_im.astype(f32), log_dt.astype(f32),
                                        b_re.astype(f32), b_im.astype(f32))
    y = uf * d_skip.astype(f32)
    for r in range(2):
        bu_re = jnp.einsum('blgc,gpc->blgp', uf, bb_re[r])
        bu_im = jnp.einsum('blgc,gpc->blgp', uf, bb_im[r])
        a_re = jnp.broadcast_to(ab_re[r], (1, L, S5_GROUPS, S5_STATE))
        a_im = jnp.broadcast_to(ab_im[r], (1, L, S5_GROUPS, S5_STATE))
        _, _, h_re, h_im = lax.associative_scan(_complex_linear_op, (a_re, a_im, bu_re, bu_im),
                                                reverse=(r == 1), axis=1)
        y = y + (jnp.einsum('blgp,gcp->blgc', h_re, c_re[r].astype(f32))
                 - jnp.einsum('blgp,gcp->blgc', h_im, c_im[r].astype(f32)))
    y = jax.nn.gelu(y.reshape(bsz, L, S5_WIDTH))
    return y * jax.nn.sigmoid(y @ w_glu.astype(f32) + b_glu.astype(f32))


def rope(x, cos, sin):
    half = x.shape[-1] // 2
    x1, x2 = x[..., :half], x[..., half:]
    return jnp.concatenate([x1 * cos - x2 * sin, x2 * cos + x1 * sin], axis=-1)


def retention_mixer(q, k, v, g, decay_logit, norm_w):
    f32 = jnp.float32
    bsz, L, _ = q.shape
    H, d, C = RET_HEADS, RET_HEAD_DIM, RET_CHUNK
    n = L // C
    pos = jnp.arange(L, dtype=f32)
    inv = ROPE_BASE ** (-jnp.arange(0, d, 2, dtype=f32) / d)
    ang = pos[:, None] * inv[None, :]
    cos = jnp.cos(ang)[:, None, :]
    sin = jnp.sin(ang)[:, None, :]
    qf = rope(q.astype(f32).reshape(bsz, L, H, d), cos, sin)
    kf = rope(k.astype(f32).reshape(bsz, L, H, d), cos, sin) * (d ** -0.5)
    vf = v.astype(f32).reshape(bsz, L, H, d)
    qc = qf.reshape(bsz, n, C, H, d)
    kc = kf.reshape(bsz, n, C, H, d)
    vc = vf.reshape(bsz, n, C, H, d)

    log_g = jax.nn.log_sigmoid(decay_logit.astype(f32))
    lf, lb = log_g[0], log_g[1]
    idx = jnp.arange(C, dtype=f32)
    diff = idx[:, None] - idx[None, :]
    mask = jnp.exp(jnp.abs(diff)[None] * jnp.where(diff[None] >= 0, lf[:, None, None], lb[:, None, None]))

    scores = jnp.einsum('bnihd,bnjhd->bnhij', qc, kc) * mask[None, None]
    out = jnp.einsum('bnhij,bnjhd->bnihd', scores, vc)

    wf = jnp.exp((C - 1.0 - idx)[:, None] * lf[None, :])
    kv_f = jnp.einsum('bnjhd,jh,bnjhe->nbhde', kc, wf, vc)
    dec_f = jnp.exp(C * lf)[None, :, None, None]

    def fwd_step(s, kv):
        return dec_f * s + kv, s

    _, s_excl = lax.scan(fwd_step, jnp.zeros((bsz, H, d, d), f32), kv_f)

    wb = jnp.exp(idx[:, None] * lb[None, :])
    kv_b = jnp.einsum('bnjhd,jh,bnjhe->nbhde', kc, wb, vc)
    dec_b = jnp.exp(C * lb)[None, :, None, None]

    def bwd_step(t, kv):
        return dec_b * t + kv, t

    _, t_excl = lax.scan(bwd_step, jnp.zeros((bsz, H, d, d), f32), kv_b, reverse=True)

    qwf = jnp.exp((idx + 1.0)[:, None] * lf[None, :])[None, None, :, :, None]
    qwb = jnp.exp((C - idx)[:, None] * lb[None, :])[None, None, :, :, None]
    out = (out + qwf * jnp.einsum('bnihd,nbhde->bnihe', qc, s_excl)
           + qwb * jnp.einsum('bnihd,nbhde->bnihe', qc, t_excl))
    out = out.reshape(bsz, L, H, d)
    out = out * lax.rsqrt(jnp.mean(out * out, axis=-1, keepdims=True) + EPS)
    out = out.reshape(bsz, L, RET_WIDTH) * norm_w.astype(f32)
    return jax.nn.silu(g.astype(f32)) * out


def mem_cross_attention(h, mem, mem_norm_w, w_cq, w_ckv, w_co):
    f32 = jnp.float32
    bsz, L, _ = h.shape
    m = rmsnorm(mem, mem_norm_w)
    q = (h @ w_cq).reshape(bsz, L, XATTN_HEADS, XATTN_HEAD_DIM).astype(f32)
    kv = (m @ w_ckv).reshape(bsz, N_MEM, 2, XATTN_HEADS, XATTN_HEAD_DIM).astype(f32)
    k, v = kv[:, :, 0], kv[:, :, 1]
    s = jnp.einsum('blhd,bmhd->bhlm', q, k) * (XATTN_HEAD_DIM ** -0.5)
    p = jax.nn.softmax(s, axis=-1)
    o = jnp.einsum('bhlm,bmhd->blhd', p, v).reshape(bsz, L, D_MODEL).astype(h.dtype)
    return o @ w_co


def swiglu(h, w_gate, w_up, w_down):
    return (jax.nn.silu(h @ w_gate) * (h @ w_up)) @ w_down


def encoder_layer(x, mem, lw):
    h = rmsnorm(x, lw['mix_norm_w'])
    z = h @ lw['w_in']
    u, q, k, v, g = jnp.split(z, [S5_WIDTH, S5_WIDTH + RET_WIDTH, S5_WIDTH + 2 * RET_WIDTH,
                                  S5_WIDTH + 3 * RET_WIDTH], axis=-1)
    y_s5 = s5_mixer(u, lw['s5_lam_re'], lw['s5_lam_im'], lw['s5_log_dt'], lw['s5_b_re'], lw['s5_b_im'],
                    lw['s5_c_re'], lw['s5_c_im'], lw['s5_d'], lw['s5_w_glu'], lw['s5_b_glu'])
    y_ret = retention_mixer(q, k, v, g, lw['ret_decay_logit'], lw['ret_norm_w'])
    mix = jnp.concatenate([y_s5, y_ret], axis=-1).astype(x.dtype)
    x = x + (mix @ lw['w_out']).astype(x.dtype)
    h = rmsnorm(x, lw['xattn_norm_w'])
    x = x + mem_cross_attention(h, mem, lw['mem_norm_w'], lw['w_cq'], lw['w_ckv'], lw['w_co']).astype(x.dtype)
    h = rmsnorm(x, lw['ffn_norm_w'])
    x = x + swiglu(h, lw['w_gate'], lw['w_up'], lw['w_down']).astype(x.dtype)
    return x


def encoder_trunk(x, mem, layers, final_norm_w):
    for i in range(DEPTH):
        lw = {name: arr[i] for name, arr in layers.items()}
        x = encoder_layer(x, mem, lw)
    return rmsnorm(x, final_norm_w)


def setup_inputs(seed: int = 0) -> dict:
    key = jax.random.key(seed)
    ks = iter(jax.random.split(key, 48))
    f32 = jnp.float32

    def nrm(shape, scale):
        return jax.random.normal(next(ks), shape, f32) * scale

    def gain(shape):
        return 1.0 + nrm(shape, 0.02)

    G, P = S5_GROUPS, S5_STATE
    n_idx = jnp.arange(P, dtype=f32)
    h_idx = jnp.arange(RET_HEADS, dtype=f32)
    return {
        'x_prompt': nrm((BATCH, SEQ, D_MODEL), 1.0),
        'x_sample': nrm((DEC_BATCH, DEC_SEQ, D_MODEL), 1.0),
        'mem_prompt': nrm((BATCH, N_MEM, D_MODEL), 1.0),
        'mem_sample': nrm((DEC_BATCH, N_MEM, D_MODEL), 1.0),
        'mix_norm_w': gain((DEPTH, D_MODEL)),
        'w_in': nrm((DEPTH, D_MODEL, IN_WIDTH), D_MODEL ** -0.5),
        's5_lam_re': -0.5 + nrm((DEPTH, 2, G, P), 0.01),
        's5_lam_im': jnp.pi * n_idx + nrm((DEPTH, 2, G, P), 0.01),
        's5_log_dt': jax.random.uniform(next(ks), (DEPTH, 2, G), f32, math.log(DT_MIN), math.log(DT_MAX)),
        's5_b_re': nrm((DEPTH, 2, G, P, S5_GROUP), (2.0 * S5_GROUP) ** -0.5),
        's5_b_im': nrm((DEPTH, 2, G, P, S5_GROUP), (2.0 * S5_GROUP) ** -0.5),
        's5_c_re': nrm((DEPTH, 2, G, S5_GROUP, P), (2.0 * P) ** -0.5),
        's5_c_im': nrm((DEPTH, 2, G, S5_GROUP, P), (2.0 * P) ** -0.5),
        's5_d': nrm((DEPTH, G, S5_GROUP), 1.0),
        's5_w_glu': nrm((DEPTH, S5_WIDTH, S5_WIDTH), S5_WIDTH ** -0.5),
        's5_b_glu': nrm((DEPTH, S5_WIDTH), 0.01),
        'ret_decay_logit': jnp.log(2.0 ** (5.0 + h_idx) - 1.0) + nrm((DEPTH, 2, RET_HEADS), 0.01),
        'ret_norm_w': gain((DEPTH, RET_WIDTH)),
        'w_out': nrm((DEPTH, D_MODEL, D_MODEL), D_MODEL ** -0.5),
        'xattn_norm_w': gain((DEPTH, D_MODEL)),
        'mem_norm_w': gain((DEPTH, D_MODEL)),
        'w_cq': nrm((DEPTH, D_MODEL, D_MODEL), D_MODEL ** -0.5),
        'w_ckv': nrm((DEPTH, D_MODEL, 2 * D_MODEL), D_MODEL ** -0.5),
        'w_co': nrm((DEPTH, D_MODEL, D_MODEL), D_MODEL ** -0.5),
        'ffn_norm_w': gain((DEPTH, D_MODEL)),
        'w_gate': nrm((DEPTH, D_MODEL, D_FF), D_MODEL ** -0.5),
        'w_up': nrm((DEPTH, D_MODEL, D_FF), D_MODEL ** -0.5),
        'w_down': nrm((DEPTH, D_FF, D_MODEL), D_FF ** -0.5),
        'final_norm_w': gain((D_MODEL,)),
    }


def reference(x_prompt, x_sample, mem_prompt, mem_sample, mix_norm_w, w_in, s5_lam_re, s5_lam_im, s5_log_dt,
              s5_b_re, s5_b_im, s5_c_re, s5_c_im, s5_d, s5_w_glu, s5_b_glu, ret_decay_logit, ret_norm_w, w_out,
              xattn_norm_w, mem_norm_w, w_cq, w_ckv, w_co, ffn_norm_w, w_gate, w_up, w_down, final_norm_w):
    layers = {
        'mix_norm_w': mix_norm_w, 'w_in': w_in,
        's5_lam_re': s5_lam_re, 's5_lam_im': s5_lam_im, 's5_log_dt': s5_log_dt,
        's5_b_re': s5_b_re, 's5_b_im': s5_b_im, 's5_c_re': s5_c_re, 's5_c_im': s5_c_im,
        's5_d': s5_d, 's5_w_glu': s5_w_glu, 's5_b_glu': s5_b_glu,
        'ret_decay_logit': ret_decay_logit, 'ret_norm_w': ret_norm_w, 'w_out': w_out,
        'xattn_norm_w': xattn_norm_w, 'mem_norm_w': mem_norm_w, 'w_cq': w_cq, 'w_ckv': w_ckv, 'w_co': w_co,
        'ffn_norm_w': ffn_norm_w, 'w_gate': w_gate, 'w_up': w_up, 'w_down': w_down,
    }
    y_prompt = encoder_trunk(x_prompt, mem_prompt, layers, final_norm_w)
    y_sample = encoder_trunk(x_sample, mem_sample, layers, final_norm_w)
    return (y_prompt, y_sample)
```

```cpp
#include <hip/hip_runtime.h>
#include <hip/hip_cooperative_groups.h>
#include <cstdio>
#include <cstdint>
#define MK_N_LAUNCHES 1
namespace pg8 {
#define PG8_LAS __attribute__((address_space(3)))
typedef unsigned short bf16_t;
typedef short bf16x8 __attribute__((ext_vector_type(8)));
typedef float f32x4 __attribute__((ext_vector_type(4)));
typedef unsigned u32x4 __attribute__((ext_vector_type(4)));
constexpr int BM = 256, BK = 64, HALF = 128, HTB = HALF * BK * 2  , STAGE_BYTES = 8 * HTB, NXCD = 8, WGM = 8;

__host__ __device__ __forceinline__ int lds_byte(int r, int c) { const int st = (r >> 4) * 2 + (c >> 5), rr = r & 15, cc = c & 31, ob = rr * 64 + cc * 2; return st * 1024 + (ob ^ (((ob >> 9) & 1) << 5)); }
__host__ __device__ __forceinline__ void stage_rc(int b, int& R, int& C) { const int st = b / 1024, sb = b % 1024, swz = sb ^ (((sb >> 9) & 1) << 5); R = (st >> 1) * 16 + swz / 64; C = (st & 1) * 32 + (swz % 64) / 2; }
__host__ __device__ __forceinline__ int perm32(int rho) { const int n = rho >> 4, i = rho & 15; return 8 * (i >> 2) + 4 * n + (i & 3); }

struct Unit { int pm, pn; };
struct Gemm { const bf16_t* A; const bf16_t* Bt; int M, N, K; };

struct StaticOrder {
    int nM, nN, nwg, G, c;
    __host__ __device__ void init(int M, int N, int G_, int c_) { nM = M / BM; nN = N / BM; nwg = nM * nN; G = G_; c = c_; }
    __host__ __device__ bool next(int i, Unit& u) const {
        const long L = (long)i * G + c; if (L >= nwg) return false;
        int wgid = (int)L; { const int q = nwg / NXCD, r = nwg % NXCD, xcd = wgid % NXCD, off = wgid / NXCD; wgid = (xcd < r ? xcd * (q + 1) : r * (q + 1) + (xcd - r) * q) + off; }
        const int nig = WGM * nN, gid = wgid / nig, fm = gid * WGM, gsz = (nM - fm) < WGM ? (nM - fm) : WGM;
        u.pm = fm + ((wgid % nig) % gsz); u.pn = (wgid % nig) / gsz; return true;
    }
    __device__ __forceinline__ void a_ready(const Unit&) const {}
    __device__ __forceinline__ void done(const Unit&) const {}
};

template <class Epi, class Sched, bool ALIGN_EPI = false, bool SP2 = false>
__device__ __forceinline__ void gemm_phase(PG8_LAS unsigned char* lds, const Gemm g, const Sched& S, const Epi& E) {
    const int tid = threadIdx.x, wid = __builtin_amdgcn_readfirstlane(tid >> 6), lane = tid & 63, wr = wid >> 2, wc = wid & 3, fr = lane & 15, fq = lane >> 4;
    const int K = g.K, nt = K / BK;
    unsigned voffA[2], voffB[2];
#pragma unroll
    for (int i = 0; i < 2; ++i) { int R, C; stage_rc(tid * 16 + i * 8192, R, C); const int Rb = Epi::PERM ? ((R & ~31) + perm32(R & 31)) : R;
        voffA[i] = (unsigned)(R * K + C) * 2u; voffB[i] = (unsigned)(Rb * K + C) * 2u; }
    const size_t kstep = (size_t)(BK * 2);
    const size_t hstep = (size_t)HALF * K * 2;
    const size_t tstep = 2 * hstep;
    const unsigned ldsw = (unsigned)wid * 1024u;
    const int aoff = lds_byte(wr * 64 + fr, fq * 8), boff = lds_byte(wc * 32 + fr, fq * 8);
#define PG8_SA(b, h) (((b) * 2 + (h)) * HTB)
#define PG8_SB(b, h) ((4 + (b) * 2 + (h)) * HTB)
#define PG8_STAGE(bufoff, gbase, voff) do { _Pragma("unroll") for (int _i = 0; _i < 2; ++_i) \
        __builtin_amdgcn_global_load_lds((const unsigned*)((const char*)(gbase) + (voff)[_i]), (PG8_LAS unsigned*)(lds + (bufoff) + ldsw + _i * 8192), 16, 0, 0); } while (0)
#define PG8_LDA(dst, b, h) do { _Pragma("unroll") for (int m = 0; m < 4; ++m) _Pragma("unroll") for (int k = 0; k < 2; ++k) dst[m][k] = *(const PG8_LAS bf16x8*)(lds + PG8_SA(b, h) + aoff + m * 2048 + k * 1024); } while (0)
#define PG8_LDB(dst, b, h) do { _Pragma("unroll") for (int n = 0; n < 2; ++n) _Pragma("unroll") for (int k = 0; k < 2; ++k) dst[n][k] = *(const PG8_LAS bf16x8*)(lds + PG8_SB(b, h) + boff + n * 2048 + k * 1024); } while (0)
#define PG8_MMA(ai, bj, At, Bt) do { __builtin_amdgcn_s_setprio(1); _Pragma("unroll") for (int m = 0; m < 4; ++m) _Pragma("unroll") for (int n = 0; n < 2; ++n) _Pragma("unroll") for (int k = 0; k < 2; ++k) \
        acc[ai][bj][m][n] = __builtin_amdgcn_mfma_f32_16x16x32_bf16(Bt[n][k], At[m][k], acc[ai][bj][m][n], 0, 0, 0); __builtin_amdgcn_s_setprio(0); } while (0)
#define PG8_WAIT_V(n) asm volatile("s_waitcnt vmcnt(" #n ")" ::: "memory")
#define PG8_WAIT_L(n) asm volatile("s_waitcnt lgkmcnt(" #n ")" ::: "memory")
#define PG8_BAR __builtin_amdgcn_s_barrier()
#define PG8_SCHED __builtin_amdgcn_sched_barrier(0)
    Unit cur, nxt; int ui = 0;
    if (!S.next(0, cur)) return;
    f32x4 acc[2][2][4][2];
#pragma unroll
    for (int a = 0; a < 2; ++a)
#pragma unroll
        for (int b = 0; b < 2; ++b)
#pragma unroll
            for (int m = 0; m < 4; ++m)
#pragma unroll
                for (int n = 0; n < 2; ++n) acc[a][b][m][n] = (f32x4){0.f, 0.f, 0.f, 0.f};
    bf16x8 At[4][2], B0[2][2], B1[2][2];
    const char* cA = (const char*)g.A + (size_t)cur.pm * tstep; const char* cB = (const char*)g.Bt + (size_t)cur.pn * tstep;
    S.a_ready(cur);
    if constexpr (SP2) {
        PG8_STAGE(PG8_SB(0, 0), cB, voffB); PG8_STAGE(PG8_SB(0, 1), cB + hstep, voffB); PG8_STAGE(PG8_SA(0, 0), cA, voffA); PG8_STAGE(PG8_SA(0, 1), cA + hstep, voffA);
        if (wr == 1) PG8_BAR;
        PG8_WAIT_V(2); PG8_BAR;
        PG8_STAGE(PG8_SB(1, 0), cB + kstep, voffB); PG8_STAGE(PG8_SA(1, 0), cA + kstep, voffA); PG8_STAGE(PG8_SB(1, 1), cB + hstep + kstep, voffB);
        PG8_WAIT_V(6); PG8_BAR;
    } else {
        PG8_STAGE(PG8_SB(0, 0), cB, voffB); PG8_STAGE(PG8_SA(0, 0), cA, voffA); PG8_STAGE(PG8_SB(0, 1), cB + hstep, voffB); PG8_STAGE(PG8_SA(0, 1), cA + hstep, voffA);
        if (wr == 1) PG8_BAR;
        PG8_WAIT_V(4); PG8_BAR;
        PG8_STAGE(PG8_SB(1, 0), cB + kstep, voffB); PG8_STAGE(PG8_SA(1, 0), cA + kstep, voffA); PG8_STAGE(PG8_SB(1, 1), cB + hstep + kstep, voffB);
        PG8_WAIT_V(6); PG8_BAR;
    }
    for (;;) {
        const bool has_next = S.next(ui + 1, nxt);
        const char* nA = has_next ? (const char*)g.A + (size_t)nxt.pm * tstep : cA; const char* nB = has_next ? (const char*)g.Bt + (size_t)nxt.pn * tstep : cB;
        for (int t = 0; t < nt; t += 2) {
            const bool last = (t == nt - 2);
            const char* a1 = cA + (size_t)(t + 1) * kstep;
            const char* a2 = last ? nA : cA + (size_t)(t + 2) * kstep; const char* b2 = last ? nB : cB + (size_t)(t + 2) * kstep;
            const char* a3 = a2 + kstep; const char* b3 = b2 + kstep;
            if (last && has_next) S.a_ready(nxt);
            if constexpr (SP2) {
            PG8_LDB(B0, 0, 0); PG8_LDB(B1, 0, 1); PG8_SCHED; PG8_LDA(At, 0, 0); PG8_STAGE(PG8_SA(1, 1), a1 + hstep, voffA);
            PG8_WAIT_V(8); PG8_WAIT_L(0); PG8_BAR; PG8_MMA(0, 0, At, B0); PG8_MMA(0, 1, At, B1); PG8_BAR; PG8_SCHED;
            PG8_LDA(At, 0, 1); PG8_STAGE(PG8_SB(0, 0), b2, voffB); PG8_STAGE(PG8_SB(0, 1), b2 + hstep, voffB); PG8_STAGE(PG8_SA(0, 0), a2, voffA);
            PG8_WAIT_V(8); PG8_WAIT_L(0); PG8_BAR; PG8_MMA(1, 0, At, B0); PG8_MMA(1, 1, At, B1); PG8_BAR; PG8_SCHED;
            PG8_LDB(B0, 1, 0); PG8_LDB(B1, 1, 1); PG8_SCHED; PG8_LDA(At, 1, 0); PG8_STAGE(PG8_SA(0, 1), a2 + hstep, voffA);
            PG8_WAIT_V(8); PG8_WAIT_L(0); PG8_BAR; PG8_MMA(0, 0, At, B0); PG8_MMA(0, 1, At, B1); PG8_BAR; PG8_SCHED;
            PG8_LDA(At, 1, 1); PG8_STAGE(PG8_SB(1, 0), b3, voffB); PG8_STAGE(PG8_SB(1, 1), b3 + hstep, voffB); PG8_STAGE(PG8_SA(1, 0), a3, voffA);
            PG8_WAIT_V(8); PG8_WAIT_L(0); PG8_BAR; PG8_MMA(1, 0, At, B0); PG8_MMA(1, 1, At, B1); PG8_BAR; PG8_SCHED;
            } else {
            PG8_LDB(B0, 0, 0); PG8_SCHED; PG8_LDA(At, 0, 0); PG8_STAGE(PG8_SA(1, 1), a1 + hstep, voffA);
            PG8_WAIT_L(8); PG8_BAR; PG8_WAIT_L(0); PG8_MMA(0, 0, At, B0); PG8_BAR; PG8_SCHED;
            PG8_LDB(B1, 0, 1); PG8_STAGE(PG8_SB(0, 0), b2, voffB);
            PG8_BAR; PG8_WAIT_L(0); PG8_MMA(0, 1, At, B1); PG8_BAR;
            PG8_LDA(At, 0, 1); PG8_STAGE(PG8_SA(0, 0), a2, voffA);
            PG8_BAR; PG8_WAIT_L(0); PG8_MMA(1, 0, At, B0); PG8_BAR; PG8_SCHED;
            PG8_STAGE(PG8_SB(0, 1), b2 + hstep, voffB);
            PG8_WAIT_V(6); PG8_BAR; PG8_MMA(1, 1, At, B1); PG8_BAR;
            PG8_LDB(B0, 1, 0); PG8_SCHED; PG8_LDA(At, 1, 0); PG8_STAGE(PG8_SA(0, 1), a2 + hstep, voffA);
            PG8_WAIT_L(8); PG8_BAR; PG8_WAIT_L(0); PG8_MMA(0, 0, At, B0); PG8_BAR; PG8_SCHED;
            PG8_LDB(B1, 1, 1); PG8_STAGE(PG8_SB(1, 0), b3, voffB);
            PG8_BAR; PG8_WAIT_L(0); PG8_MMA(0, 1, At, B1); PG8_BAR;
            PG8_LDA(At, 1, 1); PG8_STAGE(PG8_SA(1, 0), a3, voffA);
            PG8_BAR; PG8_WAIT_L(0); PG8_MMA(1, 0, At, B0); PG8_BAR; PG8_SCHED;
            PG8_STAGE(PG8_SB(1, 1), b3 + hstep, voffB);
            PG8_WAIT_V(6); PG8_BAR; PG8_MMA(1, 1, At, B1); PG8_BAR;
            }
        }
        if constexpr (ALIGN_EPI) { if (wr == 0) PG8_BAR; }
        if constexpr (!Epi::AFTER_DRAIN) { E(acc, cur, wr, wc, fr, fq); S.done(cur); }
        if (!has_next) break;
#pragma unroll
        for (int a = 0; a < 2; ++a)
#pragma unroll
            for (int b = 0; b < 2; ++b)
#pragma unroll
                for (int m = 0; m < 4; ++m)
#pragma unroll
                    for (int n = 0; n < 2; ++n) acc[a][b][m][n] = (f32x4){0.f, 0.f, 0.f, 0.f};
        cur = nxt; cA = nA; cB = nB; ++ui;
        if constexpr (ALIGN_EPI) { if (wr == 1) PG8_BAR; }
    }
    PG8_WAIT_V(0);
    if constexpr (!ALIGN_EPI) { if (wr == 0) PG8_BAR; }
    PG8_BAR;
    if constexpr (Epi::AFTER_DRAIN) { E.fused(acc, cur, wr, wc, fr, fq, lds, wid, lane); S.done(cur); }
#undef PG8_SA
#undef PG8_SB
#undef PG8_STAGE
#undef PG8_LDA
#undef PG8_LDB
#undef PG8_MMA
#undef PG8_WAIT_V
#undef PG8_WAIT_L
#undef PG8_BAR
#undef PG8_SCHED
}
}

namespace cg = cooperative_groups;
#define LAS __attribute__((address_space(3)))
typedef unsigned short bf16;
typedef short bf16x8 __attribute__((ext_vector_type(8)));
typedef short s16x4 __attribute__((ext_vector_type(4)));
typedef float f32x4 __attribute__((ext_vector_type(4)));
typedef float f32x2 __attribute__((ext_vector_type(2)));
typedef float f32x16 __attribute__((ext_vector_type(16)));
typedef unsigned u32x4 __attribute__((ext_vector_type(4)));
typedef unsigned u32x2 __attribute__((ext_vector_type(2)));
typedef __bf16 bf16x2_t __attribute__((ext_vector_type(2)));
#define DI __device__ __forceinline__
#define MFMA32(a, b, c) __builtin_amdgcn_mfma_f32_32x32x16_bf16((a), (b), (c), 0, 0, 0)
#define MFMA16(a, b, c) __builtin_amdgcn_mfma_f32_16x16x32_bf16((a), (b), (c), 0, 0, 0)

constexpr int T = 98304, TP = 32768, DM = 1024, DFF = 2816, NMR = 8704  ;
constexpr int NWAVES = 8, NTHR = 512;
constexpr float EPS = 1e-6f;
constexpr int LDS_BYTES = 147456;

constexpr size_t MiB = 1u << 20;
constexpr size_t WS_SS2 = 0, WS_SS3 = 512 * 1024;
constexpr size_t WS_BAR = 1 * MiB;
constexpr size_t WS_E = 2 * MiB;
constexpr size_t WS_RT = 8 * MiB;
constexpr size_t WS_WIN = 16 * MiB, WS_WGLU = 21 * MiB, WS_WOUT = 22 * MiB, WS_WCQ = 24 * MiB, WS_WKM = 26 * MiB, WS_WVM = 28 * MiB,
                 WS_WCO = 30 * MiB, WS_WGU = 32 * MiB, WS_WDN = 43 * MiB;
constexpr size_t WS_MN = 49 * MiB, WS_KM = 66 * MiB, WS_VTM = 83 * MiB;
constexpr size_t WS_A = 100 * MiB;
constexpr size_t SEC = 96 * MiB;
constexpr size_t WS_B1 = 628 * MiB, WS_B2 = 820 * MiB, WS_END = 1012 * MiB;

DI unsigned pk2(float lo, float hi) { f32x2 v = {lo, hi}; bf16x2_t b = __builtin_convertvector(v, bf16x2_t); return __builtin_bit_cast(unsigned, b); }
DI float bf2f(unsigned short b) { return __uint_as_float(((unsigned)b) << 16); }
DI float bflo(unsigned w) { return __uint_as_float(w << 16); }
DI float bfhi(unsigned w) { return __uint_as_float(w & 0xffff0000u); }
DI unsigned short f2bf(float f) { return (unsigned short)(pk2(f, 0.f) & 0xffffu); }
DI float sigmoidf_(float x) { return 1.f / (1.f + __expf(-x)); }
DI float gelu_tanh(float x) { const float u = 0.7978845608028654f * (x + 0.044715f * x * x * x); return x * sigmoidf_(2.f * u); }
DI u32x2 ld_l2_u32x2(const void* p) { const unsigned long long v = __hip_atomic_load((const unsigned long long*)p, __ATOMIC_RELAXED, __HIP_MEMORY_SCOPE_AGENT); u32x2 r; r.x = (unsigned)v; r.y = (unsigned)(v >> 32); return r; }
DI int swap23(int x) { return (x & 0x13) | ((x & 4) << 1) | ((x & 8) >> 1); }
DI int crow(int reg, int h) { return (reg & 3) + 8 * (reg >> 2) + 4 * h; }
DI float wave_sum(float v) {
#pragma unroll
    for (int o = 1; o < 64; o <<= 1) v += __shfl_xor(v, o);
    return v;
}
DI bf16x8 pack8(float a0, float a1, float a2, float a3, float a4, float a5, float a6, float a7) {
    u32x4 p; p.x = pk2(a0, a1); p.y = pk2(a2, a3); p.z = pk2(a4, a5); p.w = pk2(a6, a7); return __builtin_bit_cast(bf16x8, p);
}

typedef const pg8::f32x4 (&AccRef)[2][2][4][2];

struct EpiPlain {
    static constexpr bool PERM = true, AFTER_DRAIN = false;
    bf16* O; int ldc;
    DI void operator()(AccRef acc, const pg8::Unit& u, int wr, int wc, int fr, int fq) const {
        const int row0 = u.pm * 256 + wr * 64 + fr, col0 = u.pn * 256 + wc * 32 + 8 * fq;
#pragma unroll
        for (int ai = 0; ai < 2; ++ai)
#pragma unroll
            for (int m = 0; m < 4; ++m) { bf16* rowp = O + (size_t)(row0 + ai * 128 + m * 16) * ldc + col0;
#pragma unroll
                for (int bj = 0; bj < 2; ++bj) { const pg8::f32x4 v0 = acc[ai][bj][m][0], v1 = acc[ai][bj][m][1];
                    u32x4 w; w.x = pk2(v0[0], v0[1]); w.y = pk2(v0[2], v0[3]); w.z = pk2(v1[0], v1[1]); w.w = pk2(v1[2], v1[3]);
                    *(u32x4*)(rowp + bj * 128) = w; } }
    }
};
struct EpiZ {
    static constexpr bool PERM = true, AFTER_DRAIN = false;
    bf16* O; const float* RT;
    DI void operator()(AccRef acc, const pg8::Unit& u, int wr, int wc, int fr, int fq) const {
        const int t = u.pn >> 1, colt = (u.pn & 1) * 256;
        bf16* base = (bf16*)((char*)O + (size_t)t * SEC);
        const int row0 = u.pm * 256 + wr * 64 + fr, col0 = colt + wc * 32 + 8 * fq;
        const bool rope = (t == 1 || t == 2);
#pragma unroll
        for (int ai = 0; ai < 2; ++ai)
#pragma unroll
            for (int m = 0; m < 4; ++m) { const int row = row0 + ai * 128 + m * 16; bf16* rowp = base + (size_t)row * 512 + col0;
                pg8::f32x4 r0 = {1.f, 0.f, 1.f, 0.f}, r1 = {1.f, 0.f, 1.f, 0.f};
                if (rope) { const int pos = (row < TP) ? (row & 16383) : (row & 2047);
                    const pg8::f32x4* rt = (const pg8::f32x4*)(RT + ((size_t)pos * 64 + 16 * wc + 4 * fq) * 2); r0 = rt[0]; r1 = rt[1]; }
#pragma unroll
                for (int bj = 0; bj < 2; ++bj) { const pg8::f32x4 v0 = acc[ai][bj][m][0], v1 = acc[ai][bj][m][1];
                    const float a0 = v0[0] * r0[0] - v0[1] * r0[1], a1 = v0[1] * r0[0] + v0[0] * r0[1];
                    const float a2 = v0[2] * r0[2] - v0[3] * r0[3], a3 = v0[3] * r0[2] + v0[2] * r0[3];
                    const float a4 = v1[0] * r1[0] - v1[1] * r1[1], a5 = v1[1] * r1[0] + v1[0] * r1[1];
                    const float a6 = v1[2] * r1[2] - v1[3] * r1[3], a7 = v1[3] * r1[2] + v1[2] * r1[3];
                    u32x4 w; w.x = pk2(a0, a1); w.y = pk2(a2, a3); w.z = pk2(a4, a5); w.w = pk2(a6, a7);
                    if (t != 0) { const int c0 = col0 + bj * 128, hh = c0 >> 7, d0 = c0 & 127, nn = row >> 7, j = row & 127;
                        const size_t off = ((((size_t)(nn * 4 + hh) * 4 + (j >> 5)) * 8 + (d0 >> 4)) * 64 + ((d0 >> 3) & 1) * 32 + ((t == 2) ? swap23(j & 31) : (j & 31))) * 8;
                        *(u32x4*)(base + off) = w; }
                    else if (t == 0) { const int c0 = col0 + bj * 128;
                        *(u32x4*)(base + ((size_t)(c0 >> 4) * T + row) * 16 + (c0 & 15)) = w; }
                    else *(u32x4*)(rowp + bj * 128) = w; } }
    }
};
template <int MODE> struct EpiFrag {
    static constexpr bool PERM = true, AFTER_DRAIN = false;
    bf16* O;
    DI void operator()(AccRef acc, const pg8::Unit& u, int wr, int wc, int fr, int fq) const {
        const int row0 = u.pm * 256 + wr * 64 + fr, col0 = u.pn * 256 + wc * 32 + 8 * fq;
#pragma unroll
        for (int ai = 0; ai < 2; ++ai)
#pragma unroll
            for (int m = 0; m < 4; ++m) { const int r = row0 + ai * 128 + m * 16;
#pragma unroll
                for (int bj = 0; bj < 2; ++bj) { const int c0 = col0 + bj * 128; const pg8::f32x4 v0 = acc[ai][bj][m][0], v1 = acc[ai][bj][m][1];
                    u32x4 w; w.x = pk2(v0[0], v0[1]); w.y = pk2(v0[2], v0[3]); w.z = pk2(v1[0], v1[1]); w.w = pk2(v1[2], v1[3]);
                    size_t off;
                    if (MODE == 0) { const int nn = c0 >> 7, j = c0 & 127, hh = r >> 7, e = r & 127;
                        off = (((((size_t)(nn * 4 + hh) * 4 + (e >> 5)) * 4 + (j >> 5)) * 2 + ((j >> 4) & 1)) * 64 + ((j >> 3) & 1) * 32 + swap23(e & 31)) * 8; }
                    else if (MODE == 1) off = ((((size_t)((r >> 8) * 4 + (c0 >> 8)) * 8 + ((r & 255) >> 5)) * 16 + ((c0 & 255) >> 4)) * 64 + ((c0 >> 3) & 1) * 32 + swap23(r & 31)) * 8;
                    else off = (((((size_t)((c0 >> 8) * 4 + (r >> 8)) * 8 + ((r & 255) >> 5)) * 8 + ((c0 & 255) >> 5)) * 2 + ((c0 >> 4) & 1)) * 64 + ((c0 >> 3) & 1) * 32 + swap23(r & 31)) * 8;
                    *(u32x4*)(O + off) = w; } }
    }
};
struct EpiGlu {
    static constexpr bool PERM = true, AFTER_DRAIN = false;
    bf16* O; const bf16* YG; const float* bias;
    DI void operator()(AccRef acc, const pg8::Unit& u, int wr, int wc, int fr, int fq) const {
        const int row0 = u.pm * 256 + wr * 64 + fr, col0 = u.pn * 256 + wc * 32 + 8 * fq;
#pragma unroll
        for (int ai = 0; ai < 2; ++ai)
#pragma unroll
            for (int m = 0; m < 4; ++m) { const int row = row0 + ai * 128 + m * 16;
#pragma unroll
                for (int bj = 0; bj < 2; ++bj) { const int col = col0 + bj * 128;
                    const pg8::f32x4 b0 = *(const pg8::f32x4*)(bias + col), b1 = *(const pg8::f32x4*)(bias + col + 4);
                    const u32x4 y = *(const u32x4*)(YG + (size_t)row * 512 + col);
                    const pg8::f32x4 v0 = acc[ai][bj][m][0] + b0, v1 = acc[ai][bj][m][1] + b1;
                    u32x4 w;
                    w.x = pk2(bflo(y.x) * sigmoidf_(v0[0]), bfhi(y.x) * sigmoidf_(v0[1])); w.y = pk2(bflo(y.y) * sigmoidf_(v0[2]), bfhi(y.y) * sigmoidf_(v0[3]));
                    w.z = pk2(bflo(y.z) * sigmoidf_(v1[0]), bfhi(y.z) * sigmoidf_(v1[1])); w.w = pk2(bflo(y.w) * sigmoidf_(v1[2]), bfhi(y.w) * sigmoidf_(v1[3]));
                    *(u32x4*)(O + (size_t)row * 1024 + col) = w; } }
    }
};
template <bool BASE_BF16> struct EpiRes {
    static constexpr bool PERM = true, AFTER_DRAIN = false;
    const float* base0; const float* base1; const bf16* baseb; bf16* XN; float* ss;
    DI void operator()(AccRef acc, const pg8::Unit& u, int wr, int wc, int fr, int fq) const {
        const int row0 = u.pm * 256 + wr * 64 + fr, col0 = u.pn * 256 + wc * 32 + 8 * fq;
#pragma unroll
        for (int ai = 0; ai < 2; ++ai)
#pragma unroll
            for (int m = 0; m < 4; ++m) { const int row = row0 + ai * 128 + m * 16;
                const float* bp = (row < TP) ? base0 + (size_t)row * 1024 : base1 + (size_t)(row - TP) * 1024;
                float s = 0.f;
#pragma unroll
                for (int bj = 0; bj < 2; ++bj) { const int col = col0 + bj * 128;
                    pg8::f32x4 x0, x1;
                    if (BASE_BF16) { const u32x4 b = *(const u32x4*)(baseb + (size_t)row * 1024 + col);
                        x0 = (pg8::f32x4){bflo(b.x), bfhi(b.x), bflo(b.y), bfhi(b.y)} + acc[ai][bj][m][0]; x1 = (pg8::f32x4){bflo(b.z), bfhi(b.z), bflo(b.w), bfhi(b.w)} + acc[ai][bj][m][1]; }
                    else { x0 = *(const pg8::f32x4*)(bp + col) + acc[ai][bj][m][0]; x1 = *(const pg8::f32x4*)(bp + col + 4) + acc[ai][bj][m][1]; }
                    u32x4 w; w.x = pk2(x0[0], x0[1]); w.y = pk2(x0[2], x0[3]); w.z = pk2(x1[0], x1[1]); w.w = pk2(x1[2], x1[3]);
                    *(u32x4*)(XN + (size_t)row * 1024 + col) = w;
                    if (ss) { const float y0 = bflo(w.x), y1 = bfhi(w.x), y2 = bflo(w.y), y3 = bfhi(w.y), y4 = bflo(w.z), y5 = bfhi(w.z), y6 = bflo(w.w), y7 = bfhi(w.w);
                        s += ((y0 * y0 + y1 * y1) + (y2 * y2 + y3 * y3)) + ((y4 * y4 + y5 * y5) + (y6 * y6 + y7 * y7)); } }
                if (ss) { s += __shfl_xor(s, 16); s += __shfl_xor(s, 32);
                    if (fq == 0) __hip_atomic_fetch_add(ss + row, s, __ATOMIC_RELAXED, __HIP_MEMORY_SCOPE_AGENT); } }
    }
};
struct EpiScale {
    static constexpr bool PERM = true, AFTER_DRAIN = false;
    bf16* O; const float* ss;
    DI void operator()(AccRef acc, const pg8::Unit& u, int wr, int wc, int fr, int fq) const {
        const int row0 = u.pm * 256 + wr * 64 + fr, col0 = u.pn * 256 + wc * 32 + 8 * fq;
#pragma unroll
        for (int ai = 0; ai < 2; ++ai)
#pragma unroll
            for (int m = 0; m < 4; ++m) { const int row = row0 + ai * 128 + m * 16; const float ri = rsqrtf(ss[row] * (1.f / 1024.f) + EPS);
#pragma unroll
                for (int bj = 0; bj < 2; ++bj) { const pg8::f32x4 v0 = acc[ai][bj][m][0] * ri, v1 = acc[ai][bj][m][1] * ri; const int c0 = col0 + bj * 128;
                    u32x4 w; w.x = pk2(v0[0], v0[1]); w.y = pk2(v0[2], v0[3]); w.z = pk2(v1[0], v1[1]); w.w = pk2(v1[2], v1[3]);
                    *(u32x4*)(O + (((((size_t)(row >> 8) * 4 + (c0 >> 8)) * 8 + ((row & 255) >> 5)) * 16 + ((c0 & 255) >> 4)) * 64 + ((c0 >> 3) & 1) * 32 + (row & 31)) * 8) = w; } }
    }
};
struct EpiSwiglu {
    static constexpr bool PERM = true, AFTER_DRAIN = false;
    bf16* O; const float* ss;
    DI void operator()(AccRef acc, const pg8::Unit& u, int wr, int wc, int fr, int fq) const {
        const int row0 = u.pm * 256 + wr * 64 + fr, col0 = u.pn * 128 + wc * 32 + 8 * fq;
#pragma unroll
        for (int ai = 0; ai < 2; ++ai)
#pragma unroll
            for (int m = 0; m < 4; ++m) { const int row = row0 + ai * 128 + m * 16; const float ri = rsqrtf(ss[row] * (1.f / 1024.f) + EPS);
                float h[8];
#pragma unroll
                for (int n = 0; n < 2; ++n)
#pragma unroll
                    for (int e = 0; e < 4; ++e) { const float g = acc[ai][0][m][n][e] * ri, up = acc[ai][1][m][n][e] * ri; h[n * 4 + e] = g * sigmoidf_(g) * up; }
                u32x4 w; w.x = pk2(h[0], h[1]); w.y = pk2(h[2], h[3]); w.z = pk2(h[4], h[5]); w.w = pk2(h[6], h[7]);
                *(u32x4*)(O + (size_t)row * DFF + col0) = w; }
    }
};

struct Args {
    const float* in[29];
    float* out; unsigned char* ws;
    int ph_lo, ph_hi;
};
enum { I_XP = 0, I_XS, I_MP, I_MS, I_MIXNW, I_WIN, I_LRE, I_LIM, I_LDT, I_BRE, I_BIM, I_CRE, I_CIM, I_SD, I_WGLU, I_BGLU, I_DECAY, I_RNW, I_WOUT,
       I_XNW, I_MNW, I_WCQ, I_WCKV, I_WCO, I_FNW, I_WGATE, I_WUP, I_WDOWN, I_FINW };

DI void tr_item(const float* W, int ldw, int col, const float* rs, float sc, int K, bf16* WT, int n0, int k0, LAS float* scr, int lane) {
#pragma unroll 8
    for (int i = 0; i < 32; ++i) { const int kk = 2 * i + (lane >> 5); const float r = rs ? rs[k0 + kk] : 1.f; scr[kk * 33 + (lane & 31)] = W[(size_t)(k0 + kk) * ldw + col] * (r * sc); }
    asm volatile("s_waitcnt lgkmcnt(0)" ::: "memory");
    const int c = lane & 7;
#pragma unroll
    for (int j = 0; j < 4; ++j) { const int n = (lane >> 3) + 8 * j; const LAS float* s = scr + (8 * c) * 33 + n;
        u32x4 o; o.x = pk2(s[0 * 33], s[1 * 33]); o.y = pk2(s[2 * 33], s[3 * 33]); o.z = pk2(s[4 * 33], s[5 * 33]); o.w = pk2(s[6 * 33], s[7 * 33]);
        *(u32x4*)(WT + (size_t)(n0 + n) * K + k0 + 8 * c) = o; }
    asm volatile("s_waitcnt lgkmcnt(0)" ::: "memory");
}
template <int NR> DI void rms_rows_to_bf16(const float* const (&xrow)[NR], bf16* const (&orow)[NR], int lane) {
    f32x4 v[NR][4]; float s[NR];
#pragma unroll
    for (int r = 0; r < NR; ++r) { const f32x4* xr = (const f32x4*)xrow[r] + 2 * lane;
#pragma unroll
        for (int j = 0; j < 2; ++j) { v[r][2 * j] = xr[128 * j]; v[r][2 * j + 1] = xr[128 * j + 1]; } }
#pragma unroll
    for (int r = 0; r < NR; ++r) { s[r] = 0.f;
#pragma unroll
        for (int j = 0; j < 4; ++j) s[r] += (v[r][j].x * v[r][j].x + v[r][j].y * v[r][j].y) + (v[r][j].z * v[r][j].z + v[r][j].w * v[r][j].w); }
#pragma unroll
    for (int o = 1; o < 64; o <<= 1) {
#pragma unroll
        for (int r = 0; r < NR; ++r) s[r] += __shfl_xor(s[r], o); }
#pragma unroll
    for (int r = 0; r < NR; ++r) { const float ri = rsqrtf(s[r] * (1.f / 1024.f) + EPS); u32x4* o16 = (u32x4*)orow[r] + lane;
#pragma unroll
        for (int j = 0; j < 2; ++j) { u32x4 w; w.x = pk2(v[r][2 * j].x * ri, v[r][2 * j].y * ri); w.y = pk2(v[r][2 * j].z * ri, v[r][2 * j].w * ri);
            w.z = pk2(v[r][2 * j + 1].x * ri, v[r][2 * j + 1].y * ri); w.w = pk2(v[r][2 * j + 1].z * ri, v[r][2 * j + 1].w * ri); o16[64 * j] = w; } }
}
DI void p0_prologue(const Args& a, LAS unsigned char* lds, int wave, int lane) {
    unsigned char* ws = a.ws;
    LAS float* scr = (LAS float*)(lds + wave * 16384);
    const int gw = blockIdx.x * NWAVES + wave, NGW = gridDim.x * NWAVES;
    const int gt = blockIdx.x * NTHR + threadIdx.x, NGT = gridDim.x * NTHR;
    constexpr int I0 = 16 * 80, I1 = 8 * 16, I2 = 16 * 32, I7 = 16 * 176, I8 = 44 * 32;
    constexpr int NITEMS = I0 + I1 + 5 * I2 + I7 + I8;
    for (int it = gw; it < NITEMS; it += NGW) {
        int r = it; const int l31 = lane & 31;
        if (r < I0) { const int kb = r / 80, nb = r % 80, n = nb * 32 + l31; int col; float sc = 1.f;
            if (n < 512) col = n;
            else if (n < 1536) { const int sect = (n - 512) >> 9, w = (n - 512) & 511, hh = w >> 7, p = w & 127, d = (p & 1) ? (p >> 1) + 64 : (p >> 1);
                col = 512 + sect * 512 + hh * 128 + d; if (sect == 1) sc = 0.08838834764831845f; }
            else if (n < 2048) col = 2048 + (n - 1536);
            else col = 1536 + (n - 2048);
            tr_item(a.in[I_WIN], 2560, col, a.in[I_MIXNW], sc, 1024, (bf16*)(ws + WS_WIN), nb * 32, kb * 64, scr, lane); continue; } r -= I0;
        if (r < I1) { const int kb = r / 16, nb = r % 16; tr_item(a.in[I_WGLU], 512, nb * 32 + l31, nullptr, 1.f, 512, (bf16*)(ws + WS_WGLU), nb * 32, kb * 64, scr, lane); continue; } r -= I1;
        if (r < I2) { const int kb = r / 32, nb = r % 32; tr_item(a.in[I_WOUT], 1024, nb * 32 + l31, nullptr, 1.f, 1024, (bf16*)(ws + WS_WOUT), nb * 32, kb * 64, scr, lane); continue; } r -= I2;
        if (r < I2) { const int kb = r / 32, nb = r % 32; tr_item(a.in[I_WCQ], 1024, nb * 32 + l31, a.in[I_XNW], 0.0625f, 1024, (bf16*)(ws + WS_WCQ), nb * 32, kb * 64, scr, lane); continue; } r -= I2;
        if (r < I2) { const int kb = r / 32, nb = r % 32; tr_item(a.in[I_WCKV], 2048, nb * 32 + l31, a.in[I_MNW], 1.f, 1024, (bf16*)(ws + WS_WKM), nb * 32, kb * 64, scr, lane); continue; } r -= I2;
        if (r < I2) { const int kb = r / 32, nb = r % 32; tr_item(a.in[I_WCKV], 2048, 1024 + nb * 32 + l31, a.in[I_MNW], 1.f, 1024, (bf16*)(ws + WS_WVM), nb * 32, kb * 64, scr, lane); continue; } r -= I2;
        if (r < I2) { const int kb = r / 32, nb = r % 32; tr_item(a.in[I_WCO], 1024, nb * 32 + l31, nullptr, 1.f, 1024, (bf16*)(ws + WS_WCO), nb * 32, kb * 64, scr, lane); continue; } r -= I2;
        if (r < I7) { const int kb = r / 176, nb = r % 176, n0 = nb * 32, j = n0 >> 8, w = n0 & 255;
            const float* W = (w < 128) ? a.in[I_WGATE] : a.in[I_WUP];
            tr_item(W, DFF, 128 * j + (w & 127) + l31, a.in[I_FNW], 1.f, 1024, (bf16*)(ws + WS_WGU), n0, kb * 64, scr, lane); continue; } r -= I7;
        { const int kb = r / 32, nb = r % 32; tr_item(a.in[I_WDOWN], 1024, nb * 32 + l31, nullptr, 1.f, DFF, (bf16*)(ws + WS_WDN), nb * 32, kb * 64, scr, lane); }
    }
    bf16* XN = (bf16*)(ws + WS_B1); bf16* MN = (bf16*)(ws + WS_MN);
    for (int m0 = gw * 4; m0 < T; m0 += NGW * 4) { const float* xr[4]; bf16* orow[4];
#pragma unroll
        for (int r = 0; r < 4; ++r) { const int m = m0 + r; xr[r] = (m < TP) ? a.in[I_XP] + (size_t)m * 1024 : a.in[I_XS] + (size_t)(m - TP) * 1024; orow[r] = XN + (size_t)m * 1024; }
        rms_rows_to_bf16<4>(xr, orow, lane); }
    for (int m0 = gw * 4; m0 < NMR; m0 += NGW * 4) { const float* xr[4]; bf16* orow[4];
#pragma unroll
        for (int r = 0; r < 4; ++r) { const int m = m0 + r; xr[r] = (m < 512) ? a.in[I_MP] + (size_t)m * 1024 : a.in[I_MS] + (size_t)(m - 512) * 1024; orow[r] = MN + (size_t)m * 1024; }
        rms_rows_to_bf16<4>(xr, orow, lane); }
    f32x2* RT = (f32x2*)(ws + WS_RT);
    for (int i = gt; i < 16384 * 64; i += NGT) { const int pos = i >> 6, t = i & 63; const float inv = powf(10000.f, -(float)t * (1.f / 64.f)); const float ang = (float)pos * inv;
        f32x2 cs; cs.x = cosf(ang); cs.y = sinf(ang); RT[i] = cs; }
    float* ss2 = (float*)(ws + WS_SS2); float* ss3 = (float*)(ws + WS_SS3);
    for (int i = gt; i < T; i += NGT) { ss2[i] = 0.f; ss3[i] = 0.f; }
}

DI void s5_seq_range(int ci, int& cs, int& ce) { if (ci < 64) { cs = ci & ~31; ce = cs + 32; } else { cs = ci & ~3; ce = cs + 4; } }
constexpr int S5_ROWB = 528;
DI f32x2 cfma(f32x2 a, f32x2 c, f32x2 x) {
    f32x2 t, r;
    asm volatile("s_nop 0\n\tv_pk_fma_f32 %0, %2, %3, %4 op_sel:[0,0,0] op_sel_hi:[0,1,1]\n\ts_nop 1\n\t"
                 "v_pk_fma_f32 %1, %2, %3, %0 op_sel:[1,1,0] op_sel_hi:[1,0,1] neg_lo:[1,0,0]\n\ts_nop 1"
                 : "=&v"(t), "=&v"(r) : "v"(a), "v"(c), "v"(x));
    return r;
}
DI f32x2 shfl32(f32x2 v) { f32x2 r; r.x = __shfl_xor(v.x, 32); r.y = __shfl_xor(v.y, 32); return r; }
template <bool FULL>
DI void s5_sweep(const Args& a, LAS unsigned char* wl, int ci, int g, int r, int lane) {
    unsigned char* ws = a.ws;
    const bf16* U = (const bf16*)(ws + WS_A);
    f32x2* E = (f32x2*)(ws + WS_E);
    const int rg = r * 32 + g, hi = lane >> 5, n = lane & 31;
    const float dt = __expf(a.in[I_LDT][rg]);
    f32x2 A2[2]; bf16x8 bbf[4];
#pragma unroll
    for (int sh = 0; sh < 2; ++sh) { const int sj = sh * 32 + n;
        const float lre = a.in[I_LRE][rg * 64 + sj], lim = a.in[I_LIM][rg * 64 + sj]; const float mag = __expf(lre * dt);
        const float are = mag * cosf(lim * dt), aim = mag * sinf(lim * dt), den = lre * lre + lim * lim, nr = are - 1.f, ni = aim;
        A2[sh].x = are; A2[sh].y = aim;
        const float fre = (nr * lre + ni * lim) / den, fim = (ni * lre - nr * lim) / den;
        const f32x4* bre = (const f32x4*)(a.in[I_BRE] + ((size_t)rg * 64 + sj) * 16 + hi * 8); const f32x4* bim = (const f32x4*)(a.in[I_BIM] + ((size_t)rg * 64 + sj) * 16 + hi * 8);
        const f32x4 br0 = bre[0], br1 = bre[1], bi0 = bim[0], bi1 = bim[1];
        bbf[sh * 2 + 0] = pack8(fre * br0[0] - fim * bi0[0], fre * br0[1] - fim * bi0[1], fre * br0[2] - fim * bi0[2], fre * br0[3] - fim * bi0[3],
                                fre * br1[0] - fim * bi1[0], fre * br1[1] - fim * bi1[1], fre * br1[2] - fim * bi1[2], fre * br1[3] - fim * bi1[3]);
        bbf[sh * 2 + 1] = pack8(fre * bi0[0] + fim * br0[0], fre * bi0[1] + fim * br0[1], fre * bi0[2] + fim * br0[2], fre * bi0[3] + fim * br0[3],
                                fre * bi1[0] + fim * br1[0], fre * bi1[1] + fim * br1[1], fre * bi1[2] + fim * br1[2], fre * bi1[3] + fim * br1[3]); }
    f32x2 P15[2]; f32x2 A512[2];
#pragma unroll
    for (int sh = 0; sh < 2; ++sh) { double pr = A2[sh].x, pi = A2[sh].y;
#pragma unroll 1
        for (int q = 0; q < 9; ++q) { const double t0 = pr * pr - pi * pi, t1 = 2.0 * pr * pi; pr = t0; pi = t1; if (q == 3) { P15[sh].x = (float)pr; P15[sh].y = (float)pi; } }
        A512[sh].x = (float)pr; A512[sh].y = (float)pi; }
    const int quad = lane >> 4, cch = lane & 15;
    bf16x8 cmf[4];
    if (FULL) {
#pragma unroll
        for (int kk = 0; kk < 4; ++kk) { const int s0 = kk * 16 + quad * 4;
            const f32x4 cr = *(const f32x4*)(a.in[I_CRE] + ((size_t)rg * 16 + cch) * 64 + s0), cim = *(const f32x4*)(a.in[I_CIM] + ((size_t)rg * 16 + cch) * 64 + s0);
            cmf[kk] = pack8(cr[0], -cim[0], cr[1], -cim[1], cr[2], -cim[2], cr[3], -cim[3]); }
    }
    f32x2 carry[2] = {{0.f, 0.f}, {0.f, 0.f}};
    if (FULL) {
        int cs, ce; s5_seq_range(ci, cs, ce);
        const int nprev = (r == 0) ? ci - cs : ce - 1 - ci, c0 = (r == 0) ? cs : ce - 1, dc = (r == 0) ? 1 : -1;
        const f32x2* Eb = E + ((size_t)(r * 192) * 32 + g) * 64 + n;
        for (int k0 = 0; k0 < nprev; k0 += 8) { f32x2 ev[8][2];
#pragma unroll
            for (int k = 0; k < 8; ++k) { const int c = c0 + dc * min(k0 + k, nprev - 1);
                ev[k][0] = Eb[(size_t)c * 2048]; ev[k][1] = Eb[(size_t)c * 2048 + 32]; }
#pragma unroll
            for (int k = 0; k < 8; ++k) if (k0 + k < nprev) { carry[0] = cfma(A512[0], carry[0], ev[k][0]); carry[1] = cfma(A512[1], carry[1], ev[k][1]); } }
    }
    bf16* YF = (bf16*)(ws + WS_B1); bf16* YG = (bf16*)(ws + WS_B2);
    const f32x4 dsk = *(const f32x4*)(a.in[I_SD] + g * 16 + quad * 4);
    f32x16 zero16;
#pragma unroll
    for (int i = 0; i < 16; ++i) zero16[i] = 0.f;
    const int spA = 16 * ((n >> 2) & 1) + (n & 3) + 4 * (n >> 3), tokA = (r == 0) ? spA : 31 - spA;
    constexpr int PF = FULL ? 2 : 4;
    bf16x8 afr[PF]; u32x2 yfr[PF][2], uur[PF][2];
#pragma unroll
    for (int p = 0; p < PF; ++p) { const int tip = (r == 0) ? p : 15 - p; const int rowp = ci * 512 + tip * 32;
        afr[p] = *(const bf16x8*)(U + ((size_t)g * T + rowp + tokA) * 16 + hi * 8);
#pragma unroll
        for (int th = 0; th < 2; ++th) { yfr[p][th] = (u32x2){0u, 0u}; uur[p][th] = (u32x2){0u, 0u};
            if (FULL && r == 1) { const size_t idx = ((size_t)g * T + rowp + th * 16 + cch) * 16 + quad * 4; yfr[p][th] = ld_l2_u32x2(YF + idx); uur[p][th] = *(const u32x2*)(U + idx); } } }
#pragma unroll 1
    for (int tb = 0; tb < 16; tb += PF) {
#pragma unroll
      for (int us = 0; us < PF; ++us) {
        const int tt = tb + us;
        const int ti = (r == 0) ? tt : 15 - tt; const int row0 = ci * 512 + ti * 32;
        const bf16x8 af = afr[us]; const u32x2 yf0 = yfr[us][0], yf1 = yfr[us][1], uu0 = uur[us][0], uu1 = uur[us][1];
        if (tb + PF < 16) { const int rown = ci * 512 + ((r == 0) ? ti + PF : ti - PF) * 32;
            afr[us] = *(const bf16x8*)(U + ((size_t)g * T + rown + tokA) * 16 + hi * 8);
            if (FULL && r == 1) {
#pragma unroll
                for (int th = 0; th < 2; ++th) { const size_t idx = ((size_t)g * T + rown + th * 16 + cch) * 16 + quad * 4; yfr[us][th] = ld_l2_u32x2(YF + idx); uur[us][th] = *(const u32x2*)(U + idx); } } }
        const f32x16 d0 = MFMA32(af, bbf[0], zero16), d1 = MFMA32(af, bbf[1], zero16), d2 = MFMA32(af, bbf[2], zero16), d3 = MFMA32(af, bbf[3], zero16);
        if (FULL) {
            f32x2 s0 = carry[0], s1 = carry[1];
#pragma unroll
            for (int q = 0; q < 16; ++q) { f32x2 b0 = {d0[q], d1[q]}, b1 = {d2[q], d3[q]}; s0 = cfma(A2[0], s0, b0); s1 = cfma(A2[1], s1, b1); }
            { const f32x2 x0 = shfl32(s0), x1 = shfl32(s1); s0.x = hi ? x0.x : carry[0].x; s0.y = hi ? x0.y : carry[0].y; s1.x = hi ? x1.x : carry[1].x; s1.y = hi ? x1.y : carry[1].y; }
            asm volatile("" ::: "memory");
#pragma unroll
            for (int q = 0; q < 16; ++q) { const int sp = 16 * hi + q, tok = (r == 0) ? sp : 31 - sp;
                f32x2 b0 = {d0[q], d1[q]}, b1 = {d2[q], d3[q]}; s0 = cfma(A2[0], s0, b0); s1 = cfma(A2[1], s1, b1);
                *(LAS unsigned*)(wl + tok * S5_ROWB + n * 4) = pk2(s0.x, s0.y); *(LAS unsigned*)(wl + tok * S5_ROWB + (32 + n) * 4) = pk2(s1.x, s1.y); }
            asm volatile("" ::: "memory");
            carry[0] = shfl32(s0); carry[1] = shfl32(s1);
        } else {
            f32x2 s0 = {0.f, 0.f}, s1 = {0.f, 0.f};
#pragma unroll
            for (int q = 0; q < 16; ++q) { f32x2 b0 = {d0[q], d1[q]}, b1 = {d2[q], d3[q]}; s0 = cfma(A2[0], s0, b0); s1 = cfma(A2[1], s1, b1); }
            const f32x2 m0 = shfl32(cfma(P15[0], carry[0], s0)), m1 = shfl32(cfma(P15[1], carry[1], s1));
            f32x2 c0, c1; c0.x = hi ? m0.x : carry[0].x; c0.y = hi ? m0.y : carry[0].y; c1.x = hi ? m1.x : carry[1].x; c1.y = hi ? m1.y : carry[1].y;
            carry[0] = shfl32(cfma(P15[0], c0, s0)); carry[1] = shfl32(cfma(P15[1], c1, s1));
        }
        if (FULL) {
#pragma unroll
            for (int th = 0; th < 2; ++th) { f32x4 y = {0.f, 0.f, 0.f, 0.f};
#pragma unroll
                for (int kk = 0; kk < 4; ++kk) { const bf16x8 hf = *(const LAS bf16x8*)(wl + (th * 16 + cch) * S5_ROWB + kk * 64 + quad * 16); y = MFMA16(cmf[kk], hf, y); }
                const size_t idx = (size_t)(row0 + th * 16 + cch) * 512 + g * 16 + quad * 4, idg = ((size_t)g * T + row0 + th * 16 + cch) * 16 + quad * 4;
                if (r == 0) { u32x2 w; w.x = pk2(y[0], y[1]); w.y = pk2(y[2], y[3]); *(u32x2*)(YF + idg) = w; }
                else { const u32x2 yf = th ? yf1 : yf0, uu = th ? uu1 : uu0;
                    const float v0 = y[0] + bflo(yf.x) + dsk[0] * bflo(uu.x), v1 = y[1] + bfhi(yf.x) + dsk[1] * bfhi(uu.x);
                    const float v2 = y[2] + bflo(yf.y) + dsk[2] * bflo(uu.y), v3 = y[3] + bfhi(yf.y) + dsk[3] * bfhi(uu.y);
                    u32x2 w; w.x = pk2(gelu_tanh(v0), gelu_tanh(v1)); w.y = pk2(gelu_tanh(v2), gelu_tanh(v3)); *(u32x2*)(YG + idx) = w; } }
        }
        asm volatile("" ::: "memory");
        __builtin_amdgcn_sched_barrier(0);
      }
    }
    if (!FULL) { if (hi == 0) {
#pragma unroll
        for (int sh = 0; sh < 2; ++sh) E[((size_t)(r * 192 + ci) * 32 + g) * 64 + sh * 32 + n] = carry[sh]; } }
}
DI void s5_pass1(const Args& a, LAS unsigned char* lds, int wave, int lane) {
    LAS unsigned char* wl = lds + wave * (32 * S5_ROWB);
    const int gw = blockIdx.x * NWAVES + wave, NGW = gridDim.x * NWAVES;
    for (int task = gw; task < 2 * 158 * 32; task += NGW) { const int g = task & 31, cid = (task >> 5) % 158, r = (task >> 5) / 158;
        int ci; if (cid < 62) ci = (cid / 31) * 32 + cid % 31; else ci = 64 + ((cid - 62) / 3) * 4 + (cid - 62) % 3;
        if (r == 1) ci += 1;
        s5_sweep<false>(a, wl, ci, g, r, lane); }
}
DI void s5_pass3(const Args& a, LAS unsigned char* lds, int wave, int lane) {
    LAS unsigned char* wl = lds + wave * (32 * S5_ROWB);
    const int gw = blockIdx.x * NWAVES + wave, NGW = gridDim.x * NWAVES;
    for (int task = gw; task < 192 * 32; task += NGW) { const int g = task & 31, ci = task >> 5;
        s5_sweep<true>(a, wl, ci, g, 0, lane);
        asm volatile("s_waitcnt vmcnt(0)" ::: "memory");
        s5_sweep<true>(a, wl, ci, g, 1, lane); }
}

DI float log2_gamma(float logit) { return -log1pf(__expf(-logit)) * 1.4426950408889634f; }
constexpr int RA_ROWB = 272;
constexpr int RA_BLK = 32;
constexpr int RA_IMG = 128 * RA_ROWB + 4 * RA_BLK;
DI void ret_passA(const Args& a, LAS unsigned char* lds, int wave, int lane) {
    unsigned char* ws = a.ws; const int tid = threadIdx.x, hi = lane >> 5;
    const bf16* Kb = (const bf16*)(ws + WS_A + 2 * SEC); const bf16* Vt = (const bf16*)(ws + WS_A + 4 * SEC); bf16* ST = (bf16*)(ws + WS_B2);
    for (int u = blockIdx.x; u < 768 * 4; u += gridDim.x) { const int n = u >> 2, h = u & 3, tok0 = n * 128;
        const float lf2 = log2_gamma(a.in[I_DECAY][h]), lb2 = log2_gamma(a.in[I_DECAY][4 + h]);
        { const int j = tid >> 2, dq = tid & 3; const float wf = exp2f((float)(127 - j) * lf2), wb = exp2f((float)j * lb2);
#pragma unroll
            for (int q = 0; q < 4; ++q) { const int ks = dq * 2 + (q >> 1);
                const u32x4 kv = *(const u32x4*)(Kb + ((((size_t)(n * 4 + h) * 4 + (j >> 5)) * 8 + ks) * 64 + (q & 1) * 32 + swap23(j & 31)) * 8);
                const unsigned w4[4] = {kv.x, kv.y, kv.z, kv.w};
#pragma unroll
                for (int i = 0; i < 8; ++i) { const int d = dq * 32 + swap23(q * 8 + i); const float kx = (i & 1) ? bfhi(w4[i >> 1]) : bflo(w4[i >> 1]);
                    *(LAS unsigned short*)(lds + d * RA_ROWB + dq * RA_BLK + j * 2) = f2bf(kx * wf); *(LAS unsigned short*)(lds + RA_IMG + d * RA_ROWB + dq * RA_BLK + j * 2) = f2bf(kx * wb); } } }
        __syncthreads();
        const int dir = wave >> 2, et = wave & 3, l31 = lane & 31;
        f32x16 acc[4];
#pragma unroll
        for (int dt = 0; dt < 4; ++dt)
#pragma unroll
            for (int i = 0; i < 16; ++i) acc[dt][i] = 0.f;
#pragma unroll
        for (int ks = 0; ks < 8; ++ks) { const bf16x8 vf = *(const bf16x8*)(Vt + (((((size_t)(n * 4 + h) * 4 + et) * 4 + (ks >> 1)) * 2 + (ks & 1)) * 64 + lane) * 8);
#pragma unroll
            for (int dt = 0; dt < 4; ++dt) { const bf16x8 kf = *(const LAS bf16x8*)(lds + dir * RA_IMG + (dt * 32 + l31) * RA_ROWB + dt * RA_BLK + (ks * 16 + hi * 8) * 2); acc[dt] = MFMA32(kf, vf, acc[dt]); } }
        bf16* So = ST + ((size_t)(dir * 768 + n) * 4 + h) * 16384;
#pragma unroll
        for (int dt = 0; dt < 4; ++dt)
#pragma unroll
            for (int ah = 0; ah < 2; ++ah) { u32x4 w;
                w.x = pk2(acc[dt][8 * ah], acc[dt][8 * ah + 1]); w.y = pk2(acc[dt][8 * ah + 2], acc[dt][8 * ah + 3]); w.z = pk2(acc[dt][8 * ah + 4], acc[dt][8 * ah + 5]); w.w = pk2(acc[dt][8 * ah + 6], acc[dt][8 * ah + 7]);
                *(u32x4*)(So + (((size_t)(et * 8 + dt * 2 + ah) * 64) + hi * 32 + l31) * 8) = w; }
        __syncthreads();
    }
}
DI void ret_passB(const Args& a, bool dry = false) {
    unsigned char* ws = a.ws; bf16* ST = (bf16*)(ws + WS_B2);
    const int gt = blockIdx.x * NTHR + threadIdx.x, NGT = gridDim.x * NTHR;
    for (int item = gt; item < 34 * 2 * 4 * 2048; item += NGT) { const int v = item & 2047, h = (item >> 11) & 3, dir = (item >> 13) & 1, b = item >> 14;
        const int n0 = (b < 2) ? b * 128 : 256 + (b - 2) * 16, nc = (b < 2) ? 128 : 16;
        const float dec = exp2f(128.f * log2_gamma(a.in[I_DECAY][dir * 4 + h]));
        float s[8];
#pragma unroll
        for (int i = 0; i < 8; ++i) s[i] = 0.f;
        for (int q0 = 0; q0 < nc; q0 += 8) { u32x4 kv[8];
#pragma unroll
            for (int qq = 0; qq < 8; ++qq) { const int n = (dir == 0) ? n0 + q0 + qq : n0 + nc - 1 - q0 - qq; kv[qq] = *(const u32x4*)(ST + ((size_t)(dir * 768 + n) * 4 + h) * 16384 + v * 8); }
#pragma unroll
            for (int qq = 0; qq < 8; ++qq) { const int n = (dir == 0) ? n0 + q0 + qq : n0 + nc - 1 - q0 - qq;
                u32x4 o; o.x = pk2(s[0], s[1]); o.y = pk2(s[2], s[3]); o.z = pk2(s[4], s[5]); o.w = pk2(s[6], s[7]); if (dry) o = kv[qq]; *(u32x4*)(ST + ((size_t)(dir * 768 + n) * 4 + h) * 16384 + v * 8) = o;
                s[0] = dec * s[0] + bflo(kv[qq].x); s[1] = dec * s[1] + bfhi(kv[qq].x); s[2] = dec * s[2] + bflo(kv[qq].y); s[3] = dec * s[3] + bfhi(kv[qq].y);
                s[4] = dec * s[4] + bflo(kv[qq].z); s[5] = dec * s[5] + bfhi(kv[qq].z); s[6] = dec * s[6] + bflo(kv[qq].w); s[7] = dec * s[7] + bfhi(kv[qq].w); } }
    }
}
DI void ret_passC(const Args& a, int wave, int lane) {
    unsigned char* ws = a.ws; const int hi = lane >> 5, l31 = lane & 31;
    const bf16* Qb = (const bf16*)(ws + WS_A + 1 * SEC); const bf16* Kb = (const bf16*)(ws + WS_A + 2 * SEC); const bf16* Gb = (const bf16*)(ws + WS_A + 3 * SEC);
    const bf16* Vt = (const bf16*)(ws + WS_A + 4 * SEC); const bf16* ST = (const bf16*)(ws + WS_B2); bf16* MIX = (bf16*)(ws + WS_B1);
    for (int u = blockIdx.x; u < 768 * 2; u += gridDim.x) { const int n = u >> 1, h = (u & 1) * 2 + (wave >> 2), it = wave & 3, i = it * 32 + l31, tok = n * 128 + i;
        const float lf2 = log2_gamma(a.in[I_DECAY][h]), lb2 = log2_gamma(a.in[I_DECAY][4 + h]);
        bf16x8 qf[8];
#pragma unroll
        for (int ks = 0; ks < 8; ++ks) qf[ks] = *(const bf16x8*)(Qb + ((((size_t)(n * 4 + h) * 4 + it) * 8 + ks) * 64 + lane) * 8);
        const bf16* Sf = ST + ((size_t)(0 * 768 + n) * 4 + h) * 16384; const bf16* Sb = ST + ((size_t)(1 * 768 + n) * 4 + h) * 16384;
        f32x16 acc[4];
        const float qwf = exp2f((float)(i + 1) * lf2), qwb = exp2f((float)(128 - i) * lb2);
#pragma unroll
        for (int et = 0; et < 4; ++et) { f32x16 c1, c2;
#pragma unroll
            for (int q = 0; q < 16; ++q) { c1[q] = 0.f; c2[q] = 0.f; }
#pragma unroll
            for (int ks = 0; ks < 8; ++ks) { const bf16x8 a1 = *(const bf16x8*)(Sf + ((et * 8 + ks) * 64 + lane) * 8); c1 = MFMA32(a1, qf[ks], c1);
                const bf16x8 a2 = *(const bf16x8*)(Sb + ((et * 8 + ks) * 64 + lane) * 8); c2 = MFMA32(a2, qf[ks], c2); }
#pragma unroll
            for (int q = 0; q < 16; ++q) acc[et][q] = qwf * c1[q] + qwb * c2[q];
            __builtin_amdgcn_sched_barrier(0); }
#pragma unroll 1
        for (int jt = 0; jt < 4; ++jt) { f32x16 p;
#pragma unroll
            for (int q = 0; q < 16; ++q) p[q] = 0.f;
            bf16x8 ka8[8], va8[8];
#pragma unroll
            for (int ks = 0; ks < 8; ++ks) ka8[ks] = *(const bf16x8*)(Kb + ((((size_t)(n * 4 + h) * 4 + jt) * 8 + ks) * 64 + lane) * 8);
#pragma unroll
            for (int s = 0; s < 2; ++s)
#pragma unroll
                for (int et = 0; et < 4; ++et) va8[s * 4 + et] = *(const bf16x8*)(Vt + (((((size_t)(n * 4 + h) * 4 + et) * 4 + jt) * 2 + s) * 64 + lane) * 8);
            __builtin_amdgcn_sched_barrier(0);
#pragma unroll
            for (int ks = 0; ks < 8; ++ks) p = MFMA32(ka8[ks], qf[ks], p);
#pragma unroll
            for (int q = 0; q < 16; ++q) { const int dj = i - (jt * 32 + (q >> 3) * 16 + hi * 8 + (q & 7)); const float w = (dj >= 0) ? exp2f((float)dj * lf2) : exp2f((float)(-dj) * lb2); p[q] *= w; }
#pragma unroll
            for (int s = 0; s < 2; ++s) { const bf16x8 pb = pack8(p[8 * s], p[8 * s + 1], p[8 * s + 2], p[8 * s + 3], p[8 * s + 4], p[8 * s + 5], p[8 * s + 6], p[8 * s + 7]);
#pragma unroll
                for (int et = 0; et < 4; ++et) acc[et] = MFMA32(va8[s * 4 + et], pb, acc[et]);
                __builtin_amdgcn_sched_barrier(0); } }
        float ssq = 0.f;
#pragma unroll
        for (int et = 0; et < 4; ++et)
#pragma unroll
            for (int q = 0; q < 16; ++q) ssq += acc[et][q] * acc[et][q];
        ssq += __shfl_xor(ssq, 32);
        const float ri = rsqrtf(ssq * (1.f / 128.f) + EPS);
#pragma unroll
        for (int et = 0; et < 4; ++et)
#pragma unroll
            for (int ah = 0; ah < 2; ++ah) { const int e0 = et * 32 + 16 * ah + 8 * hi;
                const u32x4 gg = *(const u32x4*)(Gb + ((((size_t)(n * 4 + h) * 4 + it) * 8 + (et * 2 + ah)) * 64 + lane) * 8); const f32x4 nw0 = *(const f32x4*)(a.in[I_RNW] + h * 128 + e0), nw1 = *(const f32x4*)(a.in[I_RNW] + h * 128 + e0 + 4);
                const float g0 = bflo(gg.x), g1 = bfhi(gg.x), g2 = bflo(gg.y), g3 = bfhi(gg.y), g4 = bflo(gg.z), g5 = bfhi(gg.z), g6 = bflo(gg.w), g7 = bfhi(gg.w);
                u32x4 w;
                w.x = pk2(acc[et][8 * ah] * ri * nw0[0] * g0 * sigmoidf_(g0), acc[et][8 * ah + 1] * ri * nw0[1] * g1 * sigmoidf_(g1));
                w.y = pk2(acc[et][8 * ah + 2] * ri * nw0[2] * g2 * sigmoidf_(g2), acc[et][8 * ah + 3] * ri * nw0[3] * g3 * sigmoidf_(g3));
                w.z = pk2(acc[et][8 * ah + 4] * ri * nw1[0] * g4 * sigmoidf_(g4), acc[et][8 * ah + 5] * ri * nw1[1] * g5 * sigmoidf_(g5));
                w.w = pk2(acc[et][8 * ah + 6] * ri * nw1[2] * g6 * sigmoidf_(g6), acc[et][8 * ah + 7] * ri * nw1[3] * g7 * sigmoidf_(g7));
                *(u32x4*)(MIX + (size_t)tok * 1024 + 512 + h * 128 + e0) = w; }
    }
}

DI void xattn_phase(const Args& a, LAS unsigned char* lds, int wave, int lane) {
    unsigned char* ws = a.ws; const int hi = lane >> 5, l31 = lane & 31;
    const bf16* Qx = (const bf16*)(ws + WS_B1); const bf16* KM = (const bf16*)(ws + WS_KM); const bf16* VTM = (const bf16*)(ws + WS_VTM); bf16* O = (bf16*)(ws + WS_A);
    for (int u = blockIdx.x; u < 384 * 4; u += gridDim.x) { const int qb = u >> 2, h = u & 3, rowb = qb * 256, b = (rowb < TP) ? (rowb >> 14) : 2 + ((rowb - TP) >> 11);
        const int row = rowb + wave * 32 + l31;
        const char* Kg = (const char*)(KM + (size_t)(b * 4 + h) * 65536); const char* Vg = (const char*)(VTM + (size_t)(b * 4 + h) * 65536);
#pragma unroll
        for (int i = 0; i < 16; ++i) __builtin_amdgcn_global_load_lds((const unsigned*)(Kg + (wave * 16 + i) * 1024 + lane * 16), (LAS unsigned*)(lds + (wave * 16 + i) * 1024), 16, 0, 0);
        bf16x8 pbA[4][2], pbB[4][2]; float fA, inv_l;
        LAS unsigned char* l0 = lds + lane * 16; LAS unsigned char* l1 = lds + 65536 + lane * 16; asm volatile("" : "+v"(l1));
        {
            bf16x8 qf[16];
#pragma unroll
            for (int ks = 0; ks < 16; ++ks) qf[ks] = *(const bf16x8*)(Qx + (((((size_t)qb * 4 + h) * 8 + wave) * 16 + ks) * 64 + lane) * 8);
            asm volatile("s_waitcnt vmcnt(0)" ::: "memory"); __builtin_amdgcn_s_barrier(); asm volatile("" ::: "memory");
            __builtin_amdgcn_sched_barrier(0);
            float mA, lA;
            { f32x16 p[4];
#pragma unroll
                for (int jt = 0; jt < 4; ++jt)
#pragma unroll
                    for (int q = 0; q < 16; ++q) p[jt][q] = 0.f;
                { bf16x8 kc[4], kn[4];
#pragma unroll
                    for (int jt = 0; jt < 4; ++jt) kc[jt] = *(const LAS bf16x8*)(l0 + (jt * 16 + 0) * 1024);
#pragma unroll
                    for (int ks = 0; ks < 16; ++ks) {
                        if (ks < 15) {
#pragma unroll
                            for (int jt = 0; jt < 4; ++jt) kn[jt] = *(const LAS bf16x8*)(l0 + (jt * 16 + ks + 1) * 1024); }
                        __builtin_amdgcn_sched_barrier(0);
#pragma unroll
                        for (int jt = 0; jt < 4; ++jt) p[jt] = MFMA32(kc[jt], qf[ks], p[jt]);
                        __builtin_amdgcn_sched_barrier(0);
#pragma unroll
                        for (int jt = 0; jt < 4; ++jt) kc[jt] = kn[jt]; } }
                float mx = -3.0e38f;
#pragma unroll
                for (int jt = 0; jt < 4; ++jt)
#pragma unroll
                    for (int q = 0; q < 16; ++q) mx = fmaxf(mx, p[jt][q]);
                mA = fmaxf(mx, __shfl_xor(mx, 32));
                float sum = 0.f;
#pragma unroll
                for (int jt = 0; jt < 4; ++jt)
#pragma unroll
                    for (int q = 0; q < 16; ++q) { const float e = __builtin_amdgcn_exp2f((p[jt][q] - mA) * 1.4426950408889634f); p[jt][q] = e; sum += e; if ((q & 7) == 7) __builtin_amdgcn_sched_barrier(0); }
                lA = sum + __shfl_xor(sum, 32);
#pragma unroll
                for (int jt = 0; jt < 4; ++jt)
#pragma unroll
                    for (int s2 = 0; s2 < 2; ++s2) pbA[jt][s2] = pack8(p[jt][8 * s2], p[jt][8 * s2 + 1], p[jt][8 * s2 + 2], p[jt][8 * s2 + 3], p[jt][8 * s2 + 4], p[jt][8 * s2 + 5], p[jt][8 * s2 + 6], p[jt][8 * s2 + 7]); }
            __builtin_amdgcn_sched_barrier(0);
            { f32x16 p[4];
#pragma unroll
                for (int jt = 0; jt < 4; ++jt)
#pragma unroll
                    for (int q = 0; q < 16; ++q) p[jt][q] = 0.f;
                { bf16x8 kc[4], kn[4];
#pragma unroll
                    for (int jt = 0; jt < 4; ++jt) kc[jt] = *(const LAS bf16x8*)(l1 + (jt * 16 + 0) * 1024);
#pragma unroll
                    for (int ks = 0; ks < 16; ++ks) {
                        if (ks < 15) {
#pragma unroll
                            for (int jt = 0; jt < 4; ++jt) kn[jt] = *(const LAS bf16x8*)(l1 + (jt * 16 + ks + 1) * 1024); }
                        __builtin_amdgcn_sched_barrier(0);
#pragma unroll
                        for (int jt = 0; jt < 4; ++jt) p[jt] = MFMA32(kc[jt], qf[ks], p[jt]);
                        __builtin_amdgcn_sched_barrier(0);
#pragma unroll
                        for (int jt = 0; jt < 4; ++jt) kc[jt] = kn[jt]; } }
                asm volatile("s_waitcnt lgkmcnt(0)" ::: "memory"); __builtin_amdgcn_s_barrier(); asm volatile("" ::: "memory");
#pragma unroll
                for (int i = 0; i < 16; ++i) __builtin_amdgcn_global_load_lds((const unsigned*)(Vg + (wave * 16 + i) * 1024 + lane * 16), (LAS unsigned*)(lds + (wave * 16 + i) * 1024), 16, 0, 0);
                float mx = -3.0e38f;
#pragma unroll
                for (int jt = 0; jt < 4; ++jt)
#pragma unroll
                    for (int q = 0; q < 16; ++q) mx = fmaxf(mx, p[jt][q]);
                mx = fmaxf(mx, __shfl_xor(mx, 32));
                const float m = fmaxf(mA, mx);
                float sum = 0.f;
#pragma unroll
                for (int jt = 0; jt < 4; ++jt)
#pragma unroll
                    for (int q = 0; q < 16; ++q) { const float e = __builtin_amdgcn_exp2f((p[jt][q] - m) * 1.4426950408889634f); p[jt][q] = e; sum += e; if ((q & 7) == 7) __builtin_amdgcn_sched_barrier(0); }
                sum += __shfl_xor(sum, 32);
                fA = exp2f((mA - m) * 1.4426950408889634f); inv_l = 1.f / (fA * lA + sum);
#pragma unroll
                for (int jt = 0; jt < 4; ++jt)
#pragma unroll
                    for (int s2 = 0; s2 < 2; ++s2) pbB[jt][s2] = pack8(p[jt][8 * s2], p[jt][8 * s2 + 1], p[jt][8 * s2 + 2], p[jt][8 * s2 + 3], p[jt][8 * s2 + 4], p[jt][8 * s2 + 5], p[jt][8 * s2 + 6], p[jt][8 * s2 + 7]); }
        }
        asm volatile("s_waitcnt vmcnt(0) lgkmcnt(0)" ::: "memory"); __builtin_amdgcn_s_barrier(); asm volatile("" ::: "memory");
#pragma unroll 1
        for (int eh = 0; eh < 2; ++eh) { f32x16 acc[4]; LAS unsigned char* lv = eh ? l1 : l0;
#pragma unroll
            for (int et = 0; et < 4; ++et)
#pragma unroll
                for (int q = 0; q < 16; ++q) acc[et][q] = 0.f;
            { bf16x8 vc[4], vn[4];
#pragma unroll
                for (int et = 0; et < 4; ++et) vc[et] = *(const LAS bf16x8*)(lv + ((et * 8 + 0) * 2 + 0) * 1024);
#pragma unroll
                for (int st = 0; st < 8; ++st) { const int jt = st >> 1, s2 = st & 1;
                    if (st < 7) { const int jn = (st + 1) >> 1, sn = (st + 1) & 1;
#pragma unroll
                        for (int et = 0; et < 4; ++et) vn[et] = *(const LAS bf16x8*)(lv + ((et * 8 + jn) * 2 + sn) * 1024); }
                    __builtin_amdgcn_sched_barrier(0);
#pragma unroll
                    for (int et = 0; et < 4; ++et) acc[et] = MFMA32(vc[et], pbA[jt][s2], acc[et]);
                    __builtin_amdgcn_sched_barrier(0);
#pragma unroll
                    for (int et = 0; et < 4; ++et) vc[et] = vn[et]; } }
#pragma unroll
            for (int et = 0; et < 4; ++et)
#pragma unroll
                for (int q = 0; q < 16; ++q) acc[et][q] *= fA;
            { bf16x8 vc[4], vn[4];
#pragma unroll
                for (int et = 0; et < 4; ++et) vc[et] = *(const LAS bf16x8*)(lv + ((et * 8 + 4 + 0) * 2 + 0) * 1024);
#pragma unroll
                for (int st = 0; st < 8; ++st) { const int jt = st >> 1, s2 = st & 1;
                    if (st < 7) { const int jn = (st + 1) >> 1, sn = (st + 1) & 1;
#pragma unroll
                        for (int et = 0; et < 4; ++et) vn[et] = *(const LAS bf16x8*)(lv + ((et * 8 + 4 + jn) * 2 + sn) * 1024); }
                    __builtin_amdgcn_sched_barrier(0);
#pragma unroll
                    for (int et = 0; et < 4; ++et) acc[et] = MFMA32(vc[et], pbB[jt][s2], acc[et]);
                    __builtin_amdgcn_sched_barrier(0);
#pragma unroll
                    for (int et = 0; et < 4; ++et) vc[et] = vn[et]; } }
#pragma unroll
            for (int et = 0; et < 4; ++et)
#pragma unroll
                for (int ah = 0; ah < 2; ++ah) { const int e0 = (eh * 4 + et) * 32 + 16 * ah + 8 * hi;
                    u32x4 w; w.x = pk2(acc[et][8 * ah] * inv_l, acc[et][8 * ah + 1] * inv_l); w.y = pk2(acc[et][8 * ah + 2] * inv_l, acc[et][8 * ah + 3] * inv_l);
                    w.z = pk2(acc[et][8 * ah + 4] * inv_l, acc[et][8 * ah + 5] * inv_l); w.w = pk2(acc[et][8 * ah + 6] * inv_l, acc[et][8 * ah + 7] * inv_l);
                    *(u32x4*)(O + (size_t)row * 1024 + h * 256 + e0) = w; } }
        asm volatile("s_waitcnt lgkmcnt(0)" ::: "memory"); __builtin_amdgcn_s_barrier(); asm volatile("" ::: "memory");
    }
}

DI void final_norm(const Args& a, int wave, int lane_unused, bool dry = false) {
    const int lane = (int)__builtin_amdgcn_mbcnt_hi(~0u, __builtin_amdgcn_mbcnt_lo(~0u, 0u)); (void)lane_unused;
    const int gw = blockIdx.x * NWAVES + wave, NGW = gridDim.x * NWAVES;
    const bf16* X3 = (const bf16*)(a.ws + WS_B1);
    const f32x4* fw = (const f32x4*)a.in[I_FINW] + 2 * lane;
    f32x4 w[2][2];
#pragma unroll
    for (int j = 0; j < 2; ++j) { w[j][0] = fw[128 * j]; w[j][1] = fw[128 * j + 1]; }
    for (int m0 = gw * 4; m0 < T; m0 += NGW * 4) { u32x4 x[4][2]; float sq[4];
#pragma unroll
        for (int r = 0; r < 4; ++r) { const u32x4* xr = (const u32x4*)(X3 + (size_t)(m0 + r) * 1024) + lane; x[r][0] = xr[0]; x[r][1] = xr[64]; }
#pragma unroll
        for (int r = 0; r < 4; ++r) { sq[r] = 0.f;
#pragma unroll
            for (int j = 0; j < 2; ++j) { const unsigned w4[4] = {x[r][j].x, x[r][j].y, x[r][j].z, x[r][j].w};
#pragma unroll
                for (int e = 0; e < 4; ++e) { const float lo = bflo(w4[e]), hi2 = bfhi(w4[e]); sq[r] += lo * lo + hi2 * hi2; } } }
#pragma unroll
        for (int o = 1; o < 64; o <<= 1) {
#pragma unroll
            for (int r = 0; r < 4; ++r) sq[r] += __shfl_xor(sq[r], o); }
#pragma unroll
        for (int r = 0; r < 4; ++r) { const float ri = rsqrtf(sq[r] * (1.f / 1024.f) + EPS); f32x4* orow = (f32x4*)(a.out + (size_t)(m0 + r) * 1024) + 2 * lane;
#pragma unroll
            for (int j = 0; j < 2; ++j) { f32x4 o0, o1;
                o0[0] = bflo(x[r][j].x) * ri * w[j][0][0]; o0[1] = bfhi(x[r][j].x) * ri * w[j][0][1]; o0[2] = bflo(x[r][j].y) * ri * w[j][0][2]; o0[3] = bfhi(x[r][j].y) * ri * w[j][0][3];
                o1[0] = bflo(x[r][j].z) * ri * w[j][1][0]; o1[1] = bfhi(x[r][j].z) * ri * w[j][1][1]; o1[2] = bflo(x[r][j].w) * ri * w[j][1][2]; o1[3] = bfhi(x[r][j].w) * ri * w[j][1][3];
                orow[128 * j] = o0; orow[128 * j + 1] = o1; } } }
    (void)dry;
}

#define XB_TMO      128
#define XB_XCNT(j)  (256  + 64 * (j))
#define XB_XSUB(j)  (1280 + 64 * (j))
#define XB_XGEN(j)  (2304 + 64 * (j))
#define XB_TOP      3328
#define XB_TOPGEN   3392
#define XCD_BAR_WORDS 3456
#define XB_SPIN_CAP (1u << 18)

__device__ __forceinline__ unsigned xb_ld(unsigned* p)              { return __hip_atomic_load(p, __ATOMIC_RELAXED, __HIP_MEMORY_SCOPE_AGENT); }
__device__ __forceinline__ unsigned xb_add(unsigned* p, unsigned v) { return __hip_atomic_fetch_add(p, v, __ATOMIC_RELAXED, __HIP_MEMORY_SCOPE_AGENT); }
__device__ __forceinline__ unsigned xb_xcc_id() { return (unsigned)__builtin_amdgcn_s_getreg((3 << 11) | 20) & 0xFu; }
#define XB_SPIN(cond, bar) do { unsigned _sp = 0; while (cond) { __builtin_amdgcn_s_sleep(1); \
    if ((++_sp & 255u) == 0u) { if (xb_ld(&(bar)[XB_TMO])) break; if (_sp > XB_SPIN_CAP) { atomicAdd(&(bar)[XB_TMO], 1u); break; } } } } while (0)

struct XcdBarrier {
    unsigned* bar; unsigned x;
    volatile LAS unsigned* st;
};

__device__ __forceinline__ XcdBarrier xcd_barrier_post(unsigned* bar, volatile LAS unsigned* st) {
    XcdBarrier b; b.bar = bar; b.x = xb_xcc_id(); b.st = st;
    if (threadIdx.x == 0) (void)xb_add(&bar[XB_XCNT(b.x)], 1u);
    return b;
}
__device__ __forceinline__ void xcd_barrier_complete(unsigned* bar, unsigned x, unsigned& nloc, unsigned& nx) {
    const unsigned G = gridDim.x * gridDim.y * gridDim.z;
    unsigned sum, cnt, mine, sp = 0u;
    for (;;) {
        sum = 0u; cnt = 0u; mine = 0u;
#pragma unroll
        for (unsigned j = 0; j < 16; ++j) { const unsigned c = xb_ld(&bar[XB_XCNT(j)]); sum += c; cnt += (c > 0u) ? 1u : 0u; mine = (j == x) ? c : mine; }
        if (sum == G) break;
        __builtin_amdgcn_s_sleep(1);
        if ((++sp & 255u) == 0u) { if (xb_ld(&bar[XB_TMO])) break; if (sp > XB_SPIN_CAP) { atomicAdd(&bar[XB_TMO], 1u); break; } }
    }
    nloc = mine > 0u ? mine : 1u; nx = cnt > 0u ? cnt : 1u;
}

__device__ __forceinline__ void xcd_barrier(const XcdBarrier& b) {
    asm volatile("s_waitcnt vmcnt(0)" ::: "memory");
    __syncthreads();
    if (threadIdx.x == 0) {
        unsigned* bar = b.bar;
        __builtin_amdgcn_s_waitcnt(0);
        unsigned nloc = b.st[0], nx = b.st[1];
        if (nloc == 0u) { xcd_barrier_complete(bar, b.x, nloc, nx); b.st[0] = nloc; b.st[1] = nx; }
        const unsigned old = xb_add(&bar[XB_XSUB(b.x)], 1u);
        const unsigned gen = old / nloc;
        if (old + 1u == (gen + 1u) * nloc) {
            __builtin_amdgcn_fence(__ATOMIC_RELEASE, "agent");
            asm volatile("s_waitcnt vmcnt(0)" ::: "memory");
            const unsigned og = xb_add(&bar[XB_TOP], 1u);
            const unsigned tg = og / nx;
            if (og + 1u == (tg + 1u) * nx) xb_add(&bar[XB_TOPGEN], 1u);
            else XB_SPIN(xb_ld(&bar[XB_TOPGEN]) == tg, bar);
            __builtin_amdgcn_fence(__ATOMIC_ACQUIRE, "agent");
            xb_add(&bar[XB_XGEN(b.x)], 1u);
            asm volatile("s_waitcnt vmcnt(0)" ::: "memory");
        } else {
            XB_SPIN(xb_ld(&bar[XB_XGEN(b.x)]) == gen, bar);
            __builtin_amdgcn_fence(__ATOMIC_ACQUIRE, "agent");
            asm volatile("s_waitcnt vmcnt(0)" ::: "memory");
        }
    }
    __syncthreads();
}

constexpr int NPHASE = 15;
#ifndef MK_N_LAUNCHES
#define MK_N_LAUNCHES 1
#endif
__global__ void __launch_bounds__(NTHR) mk_fwd(Args a) {
    extern __shared__ __attribute__((aligned(16))) unsigned char lds_raw[];
    LAS unsigned char* lds = (LAS unsigned char*)lds_raw;
    cg::grid_group grid = cg::this_grid();
    const int tid = threadIdx.x, lane = tid & 63, wave = __builtin_amdgcn_readfirstlane(tid >> 6);
    unsigned char* ws = a.ws; const int lo = a.ph_lo, hi = a.ph_hi; const int G = gridDim.x, bx = blockIdx.x;
#ifndef PH_MASK
#define PH_MASK 0x7fff
#endif
#ifndef PH_REP_MASK
#define PH_REP_MASK 0
#endif
#define NREP(k) (1 + ((PH_REP_MASK >> (k)) & 1))
#define IN(k) (((PH_MASK >> (k)) & 1) && lo <= (k) && (k) < hi)
#ifndef SYNC_REP
#define SYNC_REP 1
#endif
#define SEAM(k) do { if (IN(k) && IN((k) + 1)) { if ((k) == 0) grid.sync(); else xcd_barrier(bar); } } while (0)
    volatile LAS unsigned* bar_st = (volatile LAS unsigned*)(lds + (LDS_BYTES - 64));
    if (tid < 2) bar_st[tid] = 0u;
    __syncthreads();
    const XcdBarrier bar = xcd_barrier_post((unsigned*)(ws + WS_BAR), bar_st);
    bf16* B1 = (bf16*)(ws + WS_B1); bf16* B2 = (bf16*)(ws + WS_B2); bf16* AU = (bf16*)(ws + WS_A);
    float* ss2 = (float*)(ws + WS_SS2); float* ss3 = (float*)(ws + WS_SS3);
    if (IN(0)) for (int rep_ = 0; rep_ < NREP(0); ++rep_) { p0_prologue(a, lds, wave, lane); } SEAM(0);
    if (IN(1)) for (int rep_ = 0; rep_ < NREP(1); ++rep_) {
        { pg8::Gemm g{B1, (const bf16*)(ws + WS_WIN), T, 2048, 1024}; pg8::StaticOrder S; S.init(T, 2048, G, bx); EpiZ E{AU, (const float*)(ws + WS_RT)};
          pg8::gemm_phase<EpiZ, pg8::StaticOrder, true, true>(lds, g, S, E); }
        { pg8::Gemm g{(const bf16*)(ws + WS_WIN) + (size_t)2048 * 1024, B1, 512, T, 1024}; pg8::StaticOrder S; S.init(512, T, G, bx); EpiFrag<0> E{(bf16*)(ws + WS_A + 4 * SEC)};
          pg8::gemm_phase<EpiFrag<0>, pg8::StaticOrder, true, true>(lds, g, S, E); }
        { pg8::Gemm g{(const bf16*)(ws + WS_MN), (const bf16*)(ws + WS_WKM), NMR, 1024, 1024}; pg8::StaticOrder S; S.init(NMR, 1024, G, bx); EpiFrag<1> E{(bf16*)(ws + WS_KM)};
          pg8::gemm_phase<EpiFrag<1>, pg8::StaticOrder, true, true>(lds, g, S, E); }
        { pg8::Gemm g{(const bf16*)(ws + WS_WVM), (const bf16*)(ws + WS_MN), 1024, NMR, 1024}; pg8::StaticOrder S; S.init(1024, NMR, G, bx); EpiFrag<2> E{(bf16*)(ws + WS_VTM)};
          pg8::gemm_phase<EpiFrag<2>, pg8::StaticOrder, true, true>(lds, g, S, E); }
    } SEAM(1);
    if (IN(2)) for (int rep_ = 0; rep_ < NREP(2); ++rep_) { s5_pass1(a, lds, wave, lane); } SEAM(2);
    if (IN(3)) for (int rep_ = 0; rep_ < NREP(3); ++rep_) { s5_pass3(a, lds, wave, lane); } SEAM(3);
    if (IN(4)) for (int rep_ = 0; rep_ < NREP(4); ++rep_) { pg8::Gemm g{B2, (const bf16*)(ws + WS_WGLU), T, 512, 512}; pg8::StaticOrder S; S.init(T, 512, G, bx); EpiGlu E{B1, B2, a.in[I_BGLU]};
        pg8::gemm_phase<EpiGlu, pg8::StaticOrder, true, true>(lds, g, S, E); } SEAM(4);
    if (IN(5)) for (int rep_ = 0; rep_ < NREP(5); ++rep_) { ret_passA(a, lds, wave, lane); } SEAM(5);
    if (IN(6)) for (int rep_ = 0; rep_ < NREP(6); ++rep_) { ret_passB(a, rep_ + 1 < NREP(6)); } SEAM(6);
    if (IN(7)) for (int rep_ = 0; rep_ < NREP(7); ++rep_) { ret_passC(a, wave, lane); } SEAM(7);
    if (IN(8)) for (int rep_ = 0; rep_ < NREP(8); ++rep_) { pg8::Gemm g{B1, (const bf16*)(ws + WS_WOUT), T, 1024, 1024}; pg8::StaticOrder S; S.init(T, 1024, G, bx); EpiRes<false> E{a.in[I_XP], a.in[I_XS], nullptr, B2, ss2};
        pg8::gemm_phase<EpiRes<false>, pg8::StaticOrder, true, true>(lds, g, S, E); } SEAM(8);
    if (IN(9)) for (int rep_ = 0; rep_ < NREP(9); ++rep_) { pg8::Gemm g{B2, (const bf16*)(ws + WS_WCQ), T, 1024, 1024}; pg8::StaticOrder S; S.init(T, 1024, G, bx); EpiScale E{B1, ss2};
        pg8::gemm_phase<EpiScale, pg8::StaticOrder, true, true>(lds, g, S, E); } SEAM(9);
    if (IN(10)) for (int rep_ = 0; rep_ < NREP(10); ++rep_) { xattn_phase(a, lds, wave, lane); } SEAM(10);
    if (IN(11)) for (int rep_ = 0; rep_ < NREP(11); ++rep_) { pg8::Gemm g{AU, (const bf16*)(ws + WS_WCO), T, 1024, 1024}; pg8::StaticOrder S; S.init(T, 1024, G, bx); EpiRes<true> E{nullptr, nullptr, B2, B2, ss3};
        pg8::gemm_phase<EpiRes<true>, pg8::StaticOrder, true, true>(lds, g, S, E); } SEAM(11);
    if (IN(12)) for (int rep_ = 0; rep_ < NREP(12); ++rep_) { pg8::Gemm g{B2, (const bf16*)(ws + WS_WGU), T, 2 * DFF, 1024}; pg8::StaticOrder S; S.init(T, 2 * DFF, G, bx); EpiSwiglu E{AU, ss3};
        pg8::gemm_phase<EpiSwiglu, pg8::StaticOrder, true, true>(lds, g, S, E); } SEAM(12);
    if (IN(13)) for (int rep_ = 0; rep_ < NREP(13); ++rep_) { pg8::Gemm g{AU, (const bf16*)(ws + WS_WDN), T, 1024, DFF}; pg8::StaticOrder S; S.init(T, 1024, G, bx); EpiRes<true> E{nullptr, nullptr, B2, B1, nullptr};
        pg8::gemm_phase<EpiRes<true>, pg8::StaticOrder, true, true>(lds, g, S, E); } SEAM(13);
    if (IN(14)) for (int rep_ = 0; rep_ < NREP(14); ++rep_) { final_norm(a, wave, lane, rep_ + 1 < NREP(14)); }
#undef IN
#undef SEAM
}

extern "C" void kernel_launch(void* const* d_in, const int* in_sizes, int n_in, void* d_out, int out_size, void* d_ws, size_t ws_size, hipStream_t stream) {
    static int grid = 0;
    if (grid == 0) {
        if (n_in != 29 || out_size != T * DM || ws_size < WS_END) { fprintf(stderr, "kernel_launch: unexpected shapes: n_in %d out %d ws %zu (need %zu)\n", n_in, out_size, ws_size, (size_t)WS_END); grid = -1; return; }
        int dev = 0, cus = 0;
        if (hipGetDevice(&dev) != hipSuccess || hipDeviceGetAttribute(&cus, hipDeviceAttributeMultiprocessorCount, dev) != hipSuccess) { grid = -1; return; }
        if (hipFuncSetAttribute((const void*)mk_fwd, hipFuncAttributeMaxDynamicSharedMemorySize, LDS_BYTES) != hipSuccess) { fprintf(stderr, "kernel_launch: hipFuncSetAttribute failed\n"); grid = -1; return; }
        int per_cu = 0;
        if (hipOccupancyMaxActiveBlocksPerMultiprocessor(&per_cu, (const void*)mk_fwd, NTHR, LDS_BYTES) != hipSuccess || per_cu < 1) { fprintf(stderr, "kernel_launch: occupancy query says %d\n", per_cu); per_cu = 1; }
        (void)hipGetLastError();
        grid = cus;
    }
    if (grid < 0) return;
    Args a{};
    for (int i = 0; i < 29; ++i) a.in[i] = (const float*)d_in[i];
    a.out = (float*)d_out; a.ws = (unsigned char*)d_ws;
#if MK_N_LAUNCHES == 1
    if (hipMemsetAsync((char*)d_ws + WS_BAR, 0, 16384, stream) != hipSuccess) { fprintf(stderr, "kernel_launch: hipMemsetAsync failed\n"); return; }
    a.ph_lo = 0; a.ph_hi = NPHASE;
    void* args[] = {&a};
    hipError_t e = hipLaunchCooperativeKernel((const void*)mk_fwd, dim3(grid), dim3(NTHR), args, LDS_BYTES, stream);
    if (e != hipSuccess) fprintf(stderr, "cooperative launch failed: %s (grid %d)\n", hipGetErrorString(e), grid);
#else
    for (int p = 0; p < 15; ++p) { a.ph_lo = p; a.ph_hi = p + 1; hipLaunchKernelGGL(mk_fwd, dim3(grid), dim3(NTHR), LDS_BYTES, stream, a); }
#endif
}
```

```cpp
#include <hip/hip_runtime.h>
#include <hip/hip_cooperative_groups.h>
#include <cstdio>
#include <cstdint>
#define MK_N_LAUNCHES 1
namespace pg8 {
#define PG8_LAS __attribute__((address_space(3)))
typedef unsigned short bf16_t;
typedef short bf16x8 __attribute__((ext_vector_type(8)));
typedef float f32x4 __attribute__((ext_vector_type(4)));
typedef unsigned u32x4 __attribute__((ext_vector_type(4)));
constexpr int BM = 256, BK = 64, HALF = 128, HTB = HALF * BK * 2  , STAGE_BYTES = 8 * HTB, NXCD = 8, WGM = 8;

__host__ __device__ __forceinline__ int lds_byte(int r, int c) { const int st = (r >> 4) * 2 + (c >> 5), rr = r & 15, cc = c & 31, ob = rr * 64 + cc * 2; return st * 1024 + (ob ^ (((ob >> 9) & 1) << 5)); }
__host__ __device__ __forceinline__ void stage_rc(int b, int& R, int& C) { const int st = b / 1024, sb = b % 1024, swz = sb ^ (((sb >> 9) & 1) << 5); R = (st >> 1) * 16 + swz / 64; C = (st & 1) * 32 + (swz % 64) / 2; }
__host__ __device__ __forceinline__ int perm32(int rho) { const int n = rho >> 4, i = rho & 15; return 8 * (i >> 2) + 4 * n + (i & 3); }

struct Unit { int pm, pn; };
struct Gemm { const bf16_t* A; const bf16_t* Bt; int M, N, K; };

struct StaticOrder {
    int nM, nN, nwg, G, c;
    __host__ __device__ void init(int M, int N, int G_, int c_) { nM = M / BM; nN = N / BM; nwg = nM * nN; G = G_; c = c_; }
    __host__ __device__ bool next(int i, Unit& u) const {
        const long L = (long)i * G + c; if (L >= nwg) return false;
        int wgid = (int)L; { const int q = nwg / NXCD, r = nwg % NXCD, xcd = wgid % NXCD, off = wgid / NXCD; wgid = (xcd < r ? xcd * (q + 1) : r * (q + 1) + (xcd - r) * q) + off; }
        const int nig = WGM * nN, gid = wgid / nig, fm = gid * WGM, gsz = (nM - fm) < WGM ? (nM - fm) : WGM;
        u.pm = fm + ((wgid % nig) % gsz); u.pn = (wgid % nig) / gsz; return true;
    }
    __device__ __forceinline__ void a_ready(const Unit&) const {}
    __device__ __forceinline__ void done(const Unit&) const {}
};

template <class Epi, class Sched, bool ALIGN_EPI = false, bool SP2 = false>
__device__ __forceinline__ void gemm_phase(PG8_LAS unsigned char* lds, const Gemm g, const Sched& S, const Epi& E) {
    const int tid = threadIdx.x, wid = __builtin_amdgcn_readfirstlane(tid >> 6), lane = tid & 63, wr = wid >> 2, wc = wid & 3, fr = lane & 15, fq = lane >> 4;
    const int K = g.K, nt = K / BK;
    unsigned voffA[2], voffB[2];
#pragma unroll
    for (int i = 0; i < 2; ++i) { int R, C; stage_rc(tid * 16 + i * 8192, R, C); const int Rb = Epi::PERM ? ((R & ~31) + perm32(R & 31)) : R;
        voffA[i] = (unsigned)(R * K + C) * 2u; voffB[i] = (unsigned)(Rb * K + C) * 2u; }
    const size_t kstep = (size_t)(BK * 2);
    const size_t hstep = (size_t)HALF * K * 2;
    const size_t tstep = 2 * hstep;
    const unsigned ldsw = (unsigned)wid * 1024u;
    const int aoff = lds_byte(wr * 64 + fr, fq * 8), boff = lds_byte(wc * 32 + fr, fq * 8);
#define PG8_SA(b, h) (((b) * 2 + (h)) * HTB)
#define PG8_SB(b, h) ((4 + (b) * 2 + (h)) * HTB)
#define PG8_STAGE(bufoff, gbase, voff) do { _Pragma("unroll") for (int _i = 0; _i < 2; ++_i) \
        __builtin_amdgcn_global_load_lds((const unsigned*)((const char*)(gbase) + (voff)[_i]), (PG8_LAS unsigned*)(lds + (bufoff) + ldsw + _i * 8192), 16, 0, 0); } while (0)
#define PG8_LDA(dst, b, h) do { _Pragma("unroll") for (int m = 0; m < 4; ++m) _Pragma("unroll") for (int k = 0; k < 2; ++k) dst[m][k] = *(const PG8_LAS bf16x8*)(lds + PG8_SA(b, h) + aoff + m * 2048 + k * 1024); } while (0)
#define PG8_LDB(dst, b, h) do { _Pragma("unroll") for (int n = 0; n < 2; ++n) _Pragma("unroll") for (int k = 0; k < 2; ++k) dst[n][k] = *(const PG8_LAS bf16x8*)(lds + PG8_SB(b, h) + boff + n * 2048 + k * 1024); } while (0)
#define PG8_MMA(ai, bj, At, Bt) do { __builtin_amdgcn_s_setprio(1); _Pragma("unroll") for (int m = 0; m < 4; ++m) _Pragma("unroll") for (int n = 0; n < 2; ++n) _Pragma("unroll") for (int k = 0; k < 2; ++k) \
        acc[ai][bj][m][n] = __builtin_amdgcn_mfma_f32_16x16x32_bf16(Bt[n][k], At[m][k], acc[ai][bj][m][n], 0, 0, 0); __builtin_amdgcn_s_setprio(0); } while (0)
#define PG8_WAIT_V(n) asm volatile("s_waitcnt vmcnt(" #n ")" ::: "memory")
#define PG8_WAIT_L(n) asm volatile("s_waitcnt lgkmcnt(" #n ")" ::: "memory")
#define PG8_BAR __builtin_amdgcn_s_barrier()
#define PG8_SCHED __builtin_amdgcn_sched_barrier(0)
    Unit cur, nxt; int ui = 0;
    if (!S.next(0, cur)) return;
    f32x4 acc[2][2][4][2];
#pragma unroll
    for (int a = 0; a < 2; ++a)
#pragma unroll
        for (int b = 0; b < 2; ++b)
#pragma unroll
            for (int m = 0; m < 4; ++m)
#pragma unroll
                for (int n = 0; n < 2; ++n) acc[a][b][m][n] = (f32x4){0.f, 0.f, 0.f, 0.f};
    bf16x8 At[4][2], B0[2][2], B1[2][2];
    const char* cA = (const char*)g.A + (size_t)cur.pm * tstep; const char* cB = (const char*)g.Bt + (size_t)cur.pn * tstep;
    S.a_ready(cur);
    if constexpr (SP2) {
        PG8_STAGE(PG8_SB(0, 0), cB, voffB); PG8_STAGE(PG8_SB(0, 1), cB + hstep, voffB); PG8_STAGE(PG8_SA(0, 0), cA, voffA); PG8_STAGE(PG8_SA(0, 1), cA + hstep, voffA);
        if (wr == 1) PG8_BAR;
        PG8_WAIT_V(2); PG8_BAR;
        PG8_STAGE(PG8_SB(1, 0), cB + kstep, voffB); PG8_STAGE(PG8_SA(1, 0), cA + kstep, voffA); PG8_STAGE(PG8_SB(1, 1), cB + hstep + kstep, voffB);
        PG8_WAIT_V(6); PG8_BAR;
    } else {
        PG8_STAGE(PG8_SB(0, 0), cB, voffB); PG8_STAGE(PG8_SA(0, 0), cA, voffA); PG8_STAGE(PG8_SB(0, 1), cB + hstep, voffB); PG8_STAGE(PG8_SA(0, 1), cA + hstep, voffA);
        if (wr == 1) PG8_BAR;
        PG8_WAIT_V(4); PG8_BAR;
        PG8_STAGE(PG8_SB(1, 0), cB + kstep, voffB); PG8_STAGE(PG8_SA(1, 0), cA + kstep, voffA); PG8_STAGE(PG8_SB(1, 1), cB + hstep + kstep, voffB);
        PG8_WAIT_V(6); PG8_BAR;
    }
    for (;;) {
        const bool has_next = S.next(ui + 1, nxt);
        const char* nA = has_next ? (const char*)g.A + (size_t)nxt.pm * tstep : cA; const char* nB = has_next ? (const char*)g.Bt + (size_t)nxt.pn * tstep : cB;
        for (int t = 0; t < nt; t += 2) {
            const bool last = (t == nt - 2);
            const char* a1 = cA + (size_t)(t + 1) * kstep;
            const char* a2 = last ? nA : cA + (size_t)(t + 2) * kstep; const char* b2 = last ? nB : cB + (size_t)(t + 2) * kstep;
            const char* a3 = a2 + kstep; const char* b3 = b2 + kstep;
            if (last && has_next) S.a_ready(nxt);
            if constexpr (SP2) {
            PG8_LDB(B0, 0, 0); PG8_LDB(B1, 0, 1); PG8_SCHED; PG8_LDA(At, 0, 0); PG8_STAGE(PG8_SA(1, 1), a1 + hstep, voffA);
            PG8_WAIT_V(8); PG8_WAIT_L(0); PG8_BAR; PG8_MMA(0, 0, At, B0); PG8_MMA(0, 1, At, B1); PG8_BAR; PG8_SCHED;
            PG8_LDA(At, 0, 1); PG8_STAGE(PG8_SB(0, 0), b2, voffB); PG8_STAGE(PG8_SB(0, 1), b2 + hstep, voffB); PG8_STAGE(PG8_SA(0, 0), a2, voffA);
            PG8_WAIT_V(8); PG8_WAIT_L(0); PG8_BAR; PG8_MMA(1, 0, At, B0); PG8_MMA(1, 1, At, B1); PG8_BAR; PG8_SCHED;
            PG8_LDB(B0, 1, 0); PG8_LDB(B1, 1, 1); PG8_SCHED; PG8_LDA(At, 1, 0); PG8_STAGE(PG8_SA(0, 1), a2 + hstep, voffA);
            PG8_WAIT_V(8); PG8_WAIT_L(0); PG8_BAR; PG8_MMA(0, 0, At, B0); PG8_MMA(0, 1, At, B1); PG8_BAR; PG8_SCHED;
            PG8_LDA(At, 1, 1); PG8_STAGE(PG8_SB(1, 0), b3, voffB); PG8_STAGE(PG8_SB(1, 1), b3 + hstep, voffB); PG8_STAGE(PG8_SA(1, 0), a3, voffA);
            PG8_WAIT_V(8); PG8_WAIT_L(0); PG8_BAR; PG8_MMA(1, 0, At, B0); PG8_MMA(1, 1, At, B1); PG8_BAR; PG8_SCHED;
            } else {
            PG8_LDB(B0, 0, 0); PG8_SCHED; PG8_LDA(At, 0, 0); PG8_STAGE(PG8_SA(1, 1), a1 + hstep, voffA);
            PG8_WAIT_L(8); PG8_BAR; PG8_WAIT_L(0); PG8_MMA(0, 0, At, B0); PG8_BAR; PG8_SCHED;
            PG8_LDB(B1, 0, 1); PG8_STAGE(PG8_SB(0, 0), b2, voffB);
            PG8_BAR; PG8_WAIT_L(0); PG8_MMA(0, 1, At, B1); PG8_BAR;
            PG8_LDA(At, 0, 1); PG8_STAGE(PG8_SA(0, 0), a2, voffA);
            PG8_BAR; PG8_WAIT_L(0); PG8_MMA(1, 0, At, B0); PG8_BAR; PG8_SCHED;
            PG8_STAGE(PG8_SB(0, 1), b2 + hstep, voffB);
            PG8_WAIT_V(6); PG8_BAR; PG8_MMA(1, 1, At, B1); PG8_BAR;
            PG8_LDB(B0, 1, 0); PG8_SCHED; PG8_LDA(At, 1, 0); PG8_STAGE(PG8_SA(0, 1), a2 + hstep, voffA);
            PG8_WAIT_L(8); PG8_BAR; PG8_WAIT_L(0); PG8_MMA(0, 0, At, B0); PG8_BAR; PG8_SCHED;
            PG8_LDB(B1, 1, 1); PG8_STAGE(PG8_SB(1, 0), b3, voffB);
            PG8_BAR; PG8_WAIT_L(0); PG8_MMA(0, 1, At, B1); PG8_BAR;
            PG8_LDA(At, 1, 1); PG8_STAGE(PG8_SA(1, 0), a3, voffA);
            PG8_BAR; PG8_WAIT_L(0); PG8_MMA(1, 0, At, B0); PG8_BAR; PG8_SCHED;
            PG8_STAGE(PG8_SB(1, 1), b3 + hstep, voffB);
            PG8_WAIT_V(6); PG8_BAR; PG8_MMA(1, 1, At, B1); PG8_BAR;
            }
        }
        if constexpr (ALIGN_EPI) { if (wr == 0) PG8_BAR; }
        if constexpr (!Epi::AFTER_DRAIN) { E(acc, cur, wr, wc, fr, fq); S.done(cur); }
        if (!has_next) break;
#pragma unroll
        for (int a = 0; a < 2; ++a)
#pragma unroll
            for (int b = 0; b < 2; ++b)
#pragma unroll
                for (int m = 0; m < 4; ++m)
#pragma unroll
                    for (int n = 0; n < 2; ++n) acc[a][b][m][n] = (f32x4){0.f, 0.f, 0.f, 0.f};
        cur = nxt; cA = nA; cB = nB; ++ui;
        if constexpr (ALIGN_EPI) { if (wr == 1) PG8_BAR; }
    }
    PG8_WAIT_V(0);
    if constexpr (!ALIGN_EPI) { if (wr == 0) PG8_BAR; }
    PG8_BAR;
    if constexpr (Epi::AFTER_DRAIN) { E.fused(acc, cur, wr, wc, fr, fq, lds, wid, lane); S.done(cur); }
#undef PG8_SA
#undef PG8_SB
#undef PG8_STAGE
#undef PG8_LDA
#undef PG8_LDB
#undef PG8_MMA
#undef PG8_WAIT_V
#undef PG8_WAIT_L
#undef PG8_BAR
#undef PG8_SCHED
}
}

namespace cg = cooperative_groups;
#define LAS __attribute__((address_space(3)))
typedef unsigned short bf16;
typedef short bf16x8 __attribute__((ext_vector_type(8)));
typedef short s16x4 __attribute__((ext_vector_type(4)));
typedef float f32x4 __attribute__((ext_vector_type(4)));
typedef float f32x2 __attribute__((ext_vector_type(2)));
typedef float f32x16 __attribute__((ext_vector_type(16)));
typedef unsigned u32x4 __attribute__((ext_vector_type(4)));
typedef unsigned u32x2 __attribute__((ext_vector_type(2)));
typedef __bf16 bf16x2_t __attribute__((ext_vector_type(2)));
#define DI __device__ __forceinline__
#define MFMA32(a, b, c) __builtin_amdgcn_mfma_f32_32x32x16_bf16((a), (b), (c), 0, 0, 0)
#define MFMA16(a, b, c) __builtin_amdgcn_mfma_f32_16x16x32_bf16((a), (b), (c), 0, 0, 0)

constexpr int T = 98304, TP = 32768, DM = 1024, DFF = 2816, NMR = 8704  ;
constexpr int NWAVES = 8, NTHR = 512;
constexpr float EPS = 1e-6f;
constexpr int LDS_BYTES = 147456;

constexpr size_t MiB = 1u << 20;
constexpr size_t WS_SS2 = 0, WS_SS3 = 512 * 1024;
constexpr size_t WS_BAR = 1 * MiB;
constexpr size_t WS_E = 2 * MiB;
constexpr size_t WS_RT = 8 * MiB;
constexpr size_t WS_WIN = 16 * MiB, WS_WGLU = 21 * MiB, WS_WOUT = 22 * MiB, WS_WCQ = 24 * MiB, WS_WKM = 26 * MiB, WS_WVM = 28 * MiB,
                 WS_WCO = 30 * MiB, WS_WGU = 32 * MiB, WS_WDN = 43 * MiB;
constexpr size_t WS_MN = 49 * MiB, WS_KM = 66 * MiB, WS_VTM = 83 * MiB;
constexpr size_t WS_A = 100 * MiB;
constexpr size_t SEC = 96 * MiB;
constexpr size_t WS_B1 = 628 * MiB, WS_B2 = 820 * MiB, WS_END = 1012 * MiB;

DI unsigned pk2(float lo, float hi) { f32x2 v = {lo, hi}; bf16x2_t b = __builtin_convertvector(v, bf16x2_t); return __builtin_bit_cast(unsigned, b); }
DI float bf2f(unsigned short b) { return __uint_as_float(((unsigned)b) << 16); }
DI float bflo(unsigned w) { return __uint_as_float(w << 16); }
DI float bfhi(unsigned w) { return __uint_as_float(w & 0xffff0000u); }
DI unsigned short f2bf(float f) { return (unsigned short)(pk2(f, 0.f) & 0xffffu); }
DI float sigmoidf_(float x) { return 1.f / (1.f + __expf(-x)); }
DI float gelu_tanh(float x) { const float u = 0.7978845608028654f * (x + 0.044715f * x * x * x); return x * sigmoidf_(2.f * u); }
DI u32x2 ld_l2_u32x2(const void* p) { const unsigned long long v = __hip_atomic_load((const unsigned long long*)p, __ATOMIC_RELAXED, __HIP_MEMORY_SCOPE_AGENT); u32x2 r; r.x = (unsigned)v; r.y = (unsigned)(v >> 32); return r; }
DI int swap23(int x) { return (x & 0x13) | ((x & 4) << 1) | ((x & 8) >> 1); }
DI int crow(int reg, int h) { return (reg & 3) + 8 * (reg >> 2) + 4 * h; }
DI float wave_sum(float v) {
#pragma unroll
    for (int o = 1; o < 64; o <<= 1) v += __shfl_xor(v, o);
    return v;
}
DI bf16x8 pack8(float a0, float a1, float a2, float a3, float a4, float a5, float a6, float a7) {
    u32x4 p; p.x = pk2(a0, a1); p.y = pk2(a2, a3); p.z = pk2(a4, a5); p.w = pk2(a6, a7); return __builtin_bit_cast(bf16x8, p);
}

typedef const pg8::f32x4 (&AccRef)[2][2][4][2];

struct EpiPlain {
    static constexpr bool PERM = true, AFTER_DRAIN = false;
    bf16* O; int ldc;
    DI void operator()(AccRef acc, const pg8::Unit& u, int wr, int wc, int fr, int fq) const {
        const int row0 = u.pm * 256 + wr * 64 + fr, col0 = u.pn * 256 + wc * 32 + 8 * fq;
#pragma unroll
        for (int ai = 0; ai < 2; ++ai)
#pragma unroll
            for (int m = 0; m < 4; ++m) { bf16* rowp = O + (size_t)(row0 + ai * 128 + m * 16) * ldc + col0;
#pragma unroll
                for (int bj = 0; bj < 2; ++bj) { const pg8::f32x4 v0 = acc[ai][bj][m][0], v1 = acc[ai][bj][m][1];
                    u32x4 w; w.x = pk2(v0[0], v0[1]); w.y = pk2(v0[2], v0[3]); w.z = pk2(v1[0], v1[1]); w.w = pk2(v1[2], v1[3]);
                    *(u32x4*)(rowp + bj * 128) = w; } }
    }
};
struct EpiZ {
    static constexpr bool PERM = true, AFTER_DRAIN = false;
    bf16* O; const float* RT;
    DI void operator()(AccRef acc, const pg8::Unit& u, int wr, int wc, int fr, int fq) const {
        const int t = u.pn >> 1, colt = (u.pn & 1) * 256;
        bf16* base = (bf16*)((char*)O + (size_t)t * SEC);
        const int row0 = u.pm * 256 + wr * 64 + fr, col0 = colt + wc * 32 + 8 * fq;
        const bool rope = (t == 1 || t == 2);
#pragma unroll
        for (int ai = 0; ai < 2; ++ai)
#pragma unroll
            for (int m = 0; m < 4; ++m) { const int row = row0 + ai * 128 + m * 16; bf16* rowp = base + (size_t)row * 512 + col0;
                pg8::f32x4 r0 = {1.f, 0.f, 1.f, 0.f}, r1 = {1.f, 0.f, 1.f, 0.f};
                if (rope) { const int pos = (row < TP) ? (row & 16383) : (row & 2047);
                    const pg8::f32x4* rt = (const pg8::f32x4*)(RT + ((size_t)pos * 64 + 16 * wc + 4 * fq) * 2); r0 = rt[0]; r1 = rt[1]; }
#pragma unroll
                for (int bj = 0; bj < 2; ++bj) { const pg8::f32x4 v0 = acc[ai][bj][m][0], v1 = acc[ai][bj][m][1];
                    const float a0 = v0[0] * r0[0] - v0[1] * r0[1], a1 = v0[1] * r0[0] + v0[0] * r0[1];
                    const float a2 = v0[2] * r0[2] - v0[3] * r0[3], a3 = v0[3] * r0[2] + v0[2] * r0[3];
                    const float a4 = v1[0] * r1[0] - v1[1] * r1[1], a5 = v1[1] * r1[0] + v1[0] * r1[1];
                    const float a6 = v1[2] * r1[2] - v1[3] * r1[3], a7 = v1[3] * r1[2] + v1[2] * r1[3];
                    u32x4 w; w.x = pk2(a0, a1); w.y = pk2(a2, a3); w.z = pk2(a4, a5); w.w = pk2(a6, a7);
                    if (t != 0) { const int c0 = col0 + bj * 128, hh = c0 >> 7, d0 = c0 & 127, nn = row >> 7, j = row & 127;
                        const size_t off = ((((size_t)(nn * 4 + hh) * 4 + (j >> 5)) * 8 + (d0 >> 4)) * 64 + ((d0 >> 3) & 1) * 32 + ((t == 2) ? swap23(j & 31) : (j & 31))) * 8;
                        *(u32x4*)(base + off) = w; }
                    else if (t == 0) { const int c0 = col0 + bj * 128;
                        *(u32x4*)(base + ((size_t)(c0 >> 4) * T + row) * 16 + (c0 & 15)) = w; }
                    else *(u32x4*)(rowp + bj * 128) = w; } }
    }
};
template <int MODE> struct EpiFrag {
    static constexpr bool PERM = true, AFTER_DRAIN = false;
    bf16* O;
    DI void operator()(AccRef acc, const pg8::Unit& u, int wr, int wc, int fr, int fq) const {
        const int row0 = u.pm * 256 + wr * 64 + fr, col0 = u.pn * 256 + wc * 32 + 8 * fq;
#pragma unroll
        for (int ai = 0; ai < 2; ++ai)
#pragma unroll
            for (int m = 0; m < 4; ++m) { const int r = row0 + ai * 128 + m * 16;
#pragma unroll
                for (int bj = 0; bj < 2; ++bj) { const int c0 = col0 + bj * 128; const pg8::f32x4 v0 = acc[ai][bj][m][0], v1 = acc[ai][bj][m][1];
                    u32x4 w; w.x = pk2(v0[0], v0[1]); w.y = pk2(v0[2], v0[3]); w.z = pk2(v1[0], v1[1]); w.w = pk2(v1[2], v1[3]);
                    size_t off;
                    if (MODE == 0) { const int nn = c0 >> 7, j = c0 & 127, hh = r >> 7, e = r & 127;
                        off = (((((size_t)(nn * 4 + hh) * 4 + (e >> 5)) * 4 + (j >> 5)) * 2 + ((j >> 4) & 1)) * 64 + ((j >> 3) & 1) * 32 + swap23(e & 31)) * 8; }
                    else if (MODE == 1) off = ((((size_t)((r >> 8) * 4 + (c0 >> 8)) * 8 + ((r & 255) >> 5)) * 16 + ((c0 & 255) >> 4)) * 64 + ((c0 >> 3) & 1) * 32 + swap23(r & 31)) * 8;
                    else off = (((((size_t)((c0 >> 8) * 4 + (r >> 8)) * 8 + ((r & 255) >> 5)) * 8 + ((c0 & 255) >> 5)) * 2 + ((c0 >> 4) & 1)) * 64 + ((c0 >> 3) & 1) * 32 + swap23(r & 31)) * 8;
                    *(u32x4*)(O + off) = w; } }
    }
};
struct EpiGlu {
    static constexpr bool PERM = true, AFTER_DRAIN = false;
    bf16* O; const bf16* YG; const float* bias;
    DI void operator()(AccRef acc, const pg8::Unit& u, int wr, int wc, int fr, int fq) const {
        const int row0 = u.pm * 256 + wr * 64 + fr, col0 = u.pn * 256 + wc * 32 + 8 * fq;
#pragma unroll
        for (int ai = 0; ai < 2; ++ai)
#pragma unroll
            for (int m = 0; m < 4; ++m) { const int row = row0 + ai * 128 + m * 16;
#pragma unroll
                for (int bj = 0; bj < 2; ++bj) { const int col = col0 + bj * 128;
                    const pg8::f32x4 b0 = *(const pg8::f32x4*)(bias + col), b1 = *(const pg8::f32x4*)(bias + col + 4);
                    const u32x4 y = *(const u32x4*)(YG + (size_t)row * 512 + col);
                    const pg8::f32x4 v0 = acc[ai][bj][m][0] + b0, v1 = acc[ai][bj][m][1] + b1;
                    u32x4 w;
                    w.x = pk2(bflo(y.x) * sigmoidf_(v0[0]), bfhi(y.x) * sigmoidf_(v0[1])); w.y = pk2(bflo(y.y) * sigmoidf_(v0[2]), bfhi(y.y) * sigmoidf_(v0[3]));
                    w.z = pk2(bflo(y.z) * sigmoidf_(v1[0]), bfhi(y.z) * sigmoidf_(v1[1])); w.w = pk2(bflo(y.w) * sigmoidf_(v1[2]), bfhi(y.w) * sigmoidf_(v1[3]));
                    *(u32x4*)(O + (size_t)row * 1024 + col) = w; } }
    }
};
template <bool BASE_BF16> struct EpiRes {
    static constexpr bool PERM = true, AFTER_DRAIN = false;
    const float* base0; const float* base1; const bf16* baseb; bf16* XN; float* ss;
    DI void operator()(AccRef acc, const pg8::Unit& u, int wr, int wc, int fr, int fq) const {
        const int row0 = u.pm * 256 + wr * 64 + fr, col0 = u.pn * 256 + wc * 32 + 8 * fq;
#pragma unroll
        for (int ai = 0; ai < 2; ++ai)
#pragma unroll
            for (int m = 0; m < 4; ++m) { const int row = row0 + ai * 128 + m * 16;
                const float* bp = (row < TP) ? base0 + (size_t)row * 1024 : base1 + (size_t)(row - TP) * 1024;
                float s = 0.f;
#pragma unroll
                for (int bj = 0; bj < 2; ++bj) { const int col = col0 + bj * 128;
                    pg8::f32x4 x0, x1;
                    if (BASE_BF16) { const u32x4 b = *(const u32x4*)(baseb + (size_t)row * 1024 + col);
                        x0 = (pg8::f32x4){bflo(b.x), bfhi(b.x), bflo(b.y), bfhi(b.y)} + acc[ai][bj][m][0]; x1 = (pg8::f32x4){bflo(b.z), bfhi(b.z), bflo(b.w), bfhi(b.w)} + acc[ai][bj][m][1]; }
                    else { x0 = *(const pg8::f32x4*)(bp + col) + acc[ai][bj][m][0]; x1 = *(const pg8::f32x4*)(bp + col + 4) + acc[ai][bj][m][1]; }
                    u32x4 w; w.x = pk2(x0[0], x0[1]); w.y = pk2(x0[2], x0[3]); w.z = pk2(x1[0], x1[1]); w.w = pk2(x1[2], x1[3]);
                    *(u32x4*)(XN + (size_t)row * 1024 + col) = w;
                    if (ss) { const float y0 = bflo(w.x), y1 = bfhi(w.x), y2 = bflo(w.y), y3 = bfhi(w.y), y4 = bflo(w.z), y5 = bfhi(w.z), y6 = bflo(w.w), y7 = bfhi(w.w);
                        s += ((y0 * y0 + y1 * y1) + (y2 * y2 + y3 * y3)) + ((y4 * y4 + y5 * y5) + (y6 * y6 + y7 * y7)); } }
                if (ss) { s += __shfl_xor(s, 16); s += __shfl_xor(s, 32);
                    if (fq == 0) __hip_atomic_fetch_add(ss + row, s, __ATOMIC_RELAXED, __HIP_MEMORY_SCOPE_AGENT); } }
    }
};
struct EpiScale {
    static constexpr bool PERM = true, AFTER_DRAIN = false;
    bf16* O; const float* ss;
    DI void operator()(AccRef acc, const pg8::Unit& u, int wr, int wc, int fr, int fq) const {
        const int row0 = u.pm * 256 + wr * 64 + fr, col0 = u.pn * 256 + wc * 32 + 8 * fq;
#pragma unroll
        for (int ai = 0; ai < 2; ++ai)
#pragma unroll
            for (int m = 0; m < 4; ++m) { const int row = row0 + ai * 128 + m * 16; const float ri = rsqrtf(ss[row] * (1.f / 1024.f) + EPS);
#pragma unroll
                for (int bj = 0; bj < 2; ++bj) { const pg8::f32x4 v0 = acc[ai][bj][m][0] * ri, v1 = acc[ai][bj][m][1] * ri; const int c0 = col0 + bj * 128;
                    u32x4 w; w.x = pk2(v0[0], v0[1]); w.y = pk2(v0[2], v0[3]); w.z = pk2(v1[0], v1[1]); w.w = pk2(v1[2], v1[3]);
                    *(u32x4*)(O + (((((size_t)(row >> 8) * 4 + (c0 >> 8)) * 8 + ((row & 255) >> 5)) * 16 + ((c0 & 255) >> 4)) * 64 + ((c0 >> 3) & 1) * 32 + (row & 31)) * 8) = w; } }
    }
};
struct EpiSwiglu {
    static constexpr bool PERM = true, AFTER_DRAIN = false;
    bf16* O; const float* ss;
    DI void operator()(AccRef acc, const pg8::Unit& u, int wr, int wc, int fr, int fq) const {
        const int row0 = u.pm * 256 + wr * 64 + fr, col0 = u.pn * 128 + wc * 32 + 8 * fq;
#pragma unroll
        for (int ai = 0; ai < 2; ++ai)
#pragma unroll
            for (int m = 0; m < 4; ++m) { const int row = row0 + ai * 128 + m * 16; const float ri = rsqrtf(ss[row] * (1.f / 1024.f) + EPS);
                float h[8];
#pragma unroll
                for (int n = 0; n < 2; ++n)
#pragma unroll
                    for (int e = 0; e < 4; ++e) { const float g = acc[ai][0][m][n][e] * ri, up = acc[ai][1][m][n][e] * ri; h[n * 4 + e] = g * sigmoidf_(g) * up; }
                u32x4 w; w.x = pk2(h[0], h[1]); w.y = pk2(h[2], h[3]); w.z = pk2(h[4], h[5]); w.w = pk2(h[6], h[7]);
                *(u32x4*)(O + (size_t)row * DFF + col0) = w; }
    }
};

struct Args {
    const float* in[29];
    float* out; unsigned char* ws;
    int ph_lo, ph_hi;
};
enum { I_XP = 0, I_XS, I_MP, I_MS, I_MIXNW, I_WIN, I_LRE, I_LIM, I_LDT, I_BRE, I_BIM, I_CRE, I_CIM, I_SD, I_WGLU, I_BGLU, I_DECAY, I_RNW, I_WOUT,
       I_XNW, I_MNW, I_WCQ, I_WCKV, I_WCO, I_FNW, I_WGATE, I_WUP, I_WDOWN, I_FINW };

DI void tr_item(const float* W, int ldw, int col, const float* rs, float sc, int K, bf16* WT, int n0, int k0, LAS float* scr, int lane) {
#pragma unroll 8
    for (int i = 0; i < 32; ++i) { const int kk = 2 * i + (lane >> 5); const float r = rs ? rs[k0 + kk] : 1.f; scr[kk * 33 + (lane & 31)] = W[(size_t)(k0 + kk) * ldw + col] * (r * sc); }
    asm volatile("s_waitcnt lgkmcnt(0)" ::: "memory");
    const int c = lane & 7;
#pragma unroll
    for (int j = 0; j < 4; ++j) { const int n = (lane >> 3) + 8 * j; const LAS float* s = scr + (8 * c) * 33 + n;
        u32x4 o; o.x = pk2(s[0 * 33], s[1 * 33]); o.y = pk2(s[2 * 33], s[3 * 33]); o.z = pk2(s[4 * 33], s[5 * 33]); o.w = pk2(s[6 * 33], s[7 * 33]);
        *(u32x4*)(WT + (size_t)(n0 + n) * K + k0 + 8 * c) = o; }
    asm volatile("s_waitcnt lgkmcnt(0)" ::: "memory");
}
template <int NR> DI void rms_rows_to_bf16(const float* const (&xrow)[NR], bf16* const (&orow)[NR], int lane) {
    f32x4 v[NR][4]; float s[NR];
#pragma unroll
    for (int r = 0; r < NR; ++r) { const f32x4* xr = (const f32x4*)xrow[r] + 2 * lane;
#pragma unroll
        for (int j = 0; j < 2; ++j) { v[r][2 * j] = xr[128 * j]; v[r][2 * j + 1] = xr[128 * j + 1]; } }
#pragma unroll
    for (int r = 0; r < NR; ++r) { s[r] = 0.f;
#pragma unroll
        for (int j = 0; j < 4; ++j) s[r] += (v[r][j].x * v[r][j].x + v[r][j].y * v[r][j].y) + (v[r][j].z * v[r][j].z + v[r][j].w * v[r][j].w); }
#pragma unroll
    for (int o = 1; o < 64; o <<= 1) {
#pragma unroll
        for (int r = 0; r < NR; ++r) s[r] += __shfl_xor(s[r], o); }
#pragma unroll
    for (int r = 0; r < NR; ++r) { const float ri = rsqrtf(s[r] * (1.f / 1024.f) + EPS); u32x4* o16 = (u32x4*)orow[r] + lane;
#pragma unroll
        for (int j = 0; j < 2; ++j) { u32x4 w; w.x = pk2(v[r][2 * j].x * ri, v[r][2 * j].y * ri); w.y = pk2(v[r][2 * j].z * ri, v[r][2 * j].w * ri);
            w.z = pk2(v[r][2 * j + 1].x * ri, v[r][2 * j + 1].y * ri); w.w = pk2(v[r][2 * j + 1].z * ri, v[r][2 * j + 1].w * ri); o16[64 * j] = w; } }
}
DI void p0_prologue(const Args& a, LAS unsigned char* lds, int wave, int lane) {
    unsigned char* ws = a.ws;
    LAS float* scr = (LAS float*)(lds + wave * 16384);
    const int gw = blockIdx.x * NWAVES + wave, NGW = gridDim.x * NWAVES;
    const int gt = blockIdx.x * NTHR + threadIdx.x, NGT = gridDim.x * NTHR;
    constexpr int I0 = 16 * 80, I1 = 8 * 16, I2 = 16 * 32, I7 = 16 * 176, I8 = 44 * 32;
    constexpr int NITEMS = I0 + I1 + 5 * I2 + I7 + I8;
    for (int it = gw; it < NITEMS; it += NGW) {
        int r = it; const int l31 = lane & 31;
        if (r < I0) { const int kb = r / 80, nb = r % 80, n = nb * 32 + l31; int col; float sc = 1.f;
            if (n < 512) col = n;
            else if (n < 1536) { const int sect = (n - 512) >> 9, w = (n - 512) & 511, hh = w >> 7, p = w & 127, d = (p & 1) ? (p >> 1) + 64 : (p >> 1);
                col = 512 + sect * 512 + hh * 128 + d; if (sect == 1) sc = 0.08838834764831845f; }
            else if (n < 2048) col = 2048 + (n - 1536);
            else col = 1536 + (n - 2048);
            tr_item(a.in[I_WIN], 2560, col, a.in[I_MIXNW], sc, 1024, (bf16*)(ws + WS_WIN), nb * 32, kb * 64, scr, lane); continue; } r -= I0;
        if (r < I1) { const int kb = r / 16, nb = r % 16; tr_item(a.in[I_WGLU], 512, nb * 32 + l31, nullptr, 1.f, 512, (bf16*)(ws + WS_WGLU), nb * 32, kb * 64, scr, lane); continue; } r -= I1;
        if (r < I2) { const int kb = r / 32, nb = r % 32; tr_item(a.in[I_WOUT], 1024, nb * 32 + l31, nullptr, 1.f, 1024, (bf16*)(ws + WS_WOUT), nb * 32, kb * 64, scr, lane); continue; } r -= I2;
        if (r < I2) { const int kb = r / 32, nb = r % 32; tr_item(a.in[I_WCQ], 1024, nb * 32 + l31, a.in[I_XNW], 0.0625f, 1024, (bf16*)(ws + WS_WCQ), nb * 32, kb * 64, scr, lane); continue; } r -= I2;
        if (r < I2) { const int kb = r / 32, nb = r % 32; tr_item(a.in[I_WCKV], 2048, nb * 32 + l31, a.in[I_MNW], 1.f, 1024, (bf16*)(ws + WS_WKM), nb * 32, kb * 64, scr, lane); continue; } r -= I2;
        if (r < I2) { const int kb = r / 32, nb = r % 32; tr_item(a.in[I_WCKV], 2048, 1024 + nb * 32 + l31, a.in[I_MNW], 1.f, 1024, (bf16*)(ws + WS_WVM), nb * 32, kb * 64, scr, lane); continue; } r -= I2;
        if (r < I2) { const int kb = r / 32, nb = r % 32; tr_item(a.in[I_WCO], 1024, nb * 32 + l31, nullptr, 1.f, 1024, (bf16*)(ws + WS_WCO), nb * 32, kb * 64, scr, lane); continue; } r -= I2;
        if (r < I7) { const int kb = r / 176, nb = r % 176, n0 = nb * 32, j = n0 >> 8, w = n0 & 255;
            const float* W = (w < 128) ? a.in[I_WGATE] : a.in[I_WUP];
            tr_item(W, DFF, 128 * j + (w & 127) + l31, a.in[I_FNW], 1.f, 1024, (bf16*)(ws + WS_WGU), n0, kb * 64, scr, lane); continue; } r -= I7;
        { const int kb = r / 32, nb = r % 32; tr_item(a.in[I_WDOWN], 1024, nb * 32 + l31, nullptr, 1.f, DFF, (bf16*)(ws + WS_WDN), nb * 32, kb * 64, scr, lane); }
    }
    bf16* XN = (bf16*)(ws + WS_B1); bf16* MN = (bf16*)(ws + WS_MN);
    for (int m0 = gw * 4; m0 < T; m0 += NGW * 4) { const float* xr[4]; bf16* orow[4];
#pragma unroll
        for (int r = 0; r < 4; ++r) { const int m = m0 + r; xr[r] = (m < TP) ? a.in[I_XP] + (size_t)m * 1024 : a.in[I_XS] + (size_t)(m - TP) * 1024; orow[r] = XN + (size_t)m * 1024; }
        rms_rows_to_bf16<4>(xr, orow, lane); }
    for (int m0 = gw * 4; m0 < NMR; m0 += NGW * 4) { const float* xr[4]; bf16* orow[4];
#pragma unroll
        for (int r = 0; r < 4; ++r) { const int m = m0 + r; xr[r] = (m < 512) ? a.in[I_MP] + (size_t)m * 1024 : a.in[I_MS] + (size_t)(m - 512) * 1024; orow[r] = MN + (size_t)m * 1024; }
        rms_rows_to_bf16<4>(xr, orow, lane); }
    f32x2* RT = (f32x2*)(ws + WS_RT);
    for (int i = gt; i < 16384 * 64; i += NGT) { const int pos = i >> 6, t = i & 63; const float inv = powf(10000.f, -(float)t * (1.f / 64.f)); const float ang = (float)pos * inv;
        f32x2 cs; cs.x = cosf(ang); cs.y = sinf(ang); RT[i] = cs; }
    float* ss2 = (float*)(ws + WS_SS2); float* ss3 = (float*)(ws + WS_SS3);
    for (int i = gt; i < T; i += NGT) { ss2[i] = 0.f; ss3[i] = 0.f; }
}

DI void s5_seq_range(int ci, int& cs, int& ce) { if (ci < 64) { cs = ci & ~31; ce = cs + 32; } else { cs = ci & ~3; ce = cs + 4; } }
constexpr int S5_ROWB = 528;
DI f32x2 cfma(f32x2 a, f32x2 c, f32x2 x) {
    f32x2 t, r;
    asm volatile("s_nop 0\n\tv_pk_fma_f32 %0, %2, %3, %4 op_sel:[0,0,0] op_sel_hi:[0,1,1]\n\ts_nop 1\n\t"
                 "v_pk_fma_f32 %1, %2, %3, %0 op_sel:[1,1,0] op_sel_hi:[1,0,1] neg_lo:[1,0,0]\n\ts_nop 1"
                 : "=&v"(t), "=&v"(r) : "v"(a), "v"(c), "v"(x));
    return r;
}
DI f32x2 shfl32(f32x2 v) { f32x2 r; r.x = __shfl_xor(v.x, 32); r.y = __shfl_xor(v.y, 32); return r; }
template <bool FULL>
DI void s5_sweep(const Args& a, LAS unsigned char* wl, int ci, int g, int r, int lane) {
    unsigned char* ws = a.ws;
    const bf16* U = (const bf16*)(ws + WS_A);
    f32x2* E = (f32x2*)(ws + WS_E);
    const int rg = r * 32 + g, hi = lane >> 5, n = lane & 31;
    const float dt = __expf(a.in[I_LDT][rg]);
    f32x2 A2[2]; bf16x8 bbf[4];
#pragma unroll
    for (int sh = 0; sh < 2; ++sh) { const int sj = sh * 32 + n;
        const float lre = a.in[I_LRE][rg * 64 + sj], lim = a.in[I_LIM][rg * 64 + sj]; const float mag = __expf(lre * dt);
        const float are = mag * cosf(lim * dt), aim = mag * sinf(lim * dt), den = lre * lre + lim * lim, nr = are - 1.f, ni = aim;
        A2[sh].x = are; A2[sh].y = aim;
        const float fre = (nr * lre + ni * lim) / den, fim = (ni * lre - nr * lim) / den;
        const f32x4* bre = (const f32x4*)(a.in[I_BRE] + ((size_t)rg * 64 + sj) * 16 + hi * 8); const f32x4* bim = (const f32x4*)(a.in[I_BIM] + ((size_t)rg * 64 + sj) * 16 + hi * 8);
        const f32x4 br0 = bre[0], br1 = bre[1], bi0 = bim[0], bi1 = bim[1];
        bbf[sh * 2 + 0] = pack8(fre * br0[0] - fim * bi0[0], fre * br0[1] - fim * bi0[1], fre * br0[2] - fim * bi0[2], fre * br0[3] - fim * bi0[3],
                                fre * br1[0] - fim * bi1[0], fre * br1[1] - fim * bi1[1], fre * br1[2] - fim * bi1[2], fre * br1[3] - fim * bi1[3]);
        bbf[sh * 2 + 1] = pack8(fre * bi0[0] + fim * br0[0], fre * bi0[1] + fim * br0[1], fre * bi0[2] + fim * br0[2], fre * bi0[3] + fim * br0[3],
                                fre * bi1[0] + fim * br1[0], fre * bi1[1] + fim * br1[1], fre * bi1[2] + fim * br1[2], fre * bi1[3] + fim * br1[3]); }
    f32x2 P15[2]; f32x2 A512[2];
#pragma unroll
    for (int sh = 0; sh < 2; ++sh) { double pr = A2[sh].x, pi = A2[sh].y;
#pragma unroll 1
        for (int q = 0; q < 9; ++q) { const double t0 = pr * pr - pi * pi, t1 = 2.0 * pr * pi; pr = t0; pi = t1; if (q == 3) { P15[sh].x = (float)pr; P15[sh].y = (float)pi; } }
        A512[sh].x = (float)pr; A512[sh].y = (float)pi; }
    const int quad = lane >> 4, cch = lane & 15;
    bf16x8 cmf[4];
    if (FULL) {
#pragma unroll
        for (int kk = 0; kk < 4; ++kk) { const int s0 = kk * 16 + quad * 4;
            const f32x4 cr = *(const f32x4*)(a.in[I_CRE] + ((size_t)rg * 16 + cch) * 64 + s0), cim = *(const f32x4*)(a.in[I_CIM] + ((size_t)rg * 16 + cch) * 64 + s0);
            cmf[kk] = pack8(cr[0], -cim[0], cr[1], -cim[1], cr[2], -cim[2], cr[3], -cim[3]); }
    }
    f32x2 carry[2] = {{0.f, 0.f}, {0.f, 0.f}};
    if (FULL) {
        int cs, ce; s5_seq_range(ci, cs, ce);
        const int nprev = (r == 0) ? ci - cs : ce - 1 - ci, c0 = (r == 0) ? cs : ce - 1, dc = (r == 0) ? 1 : -1;
        const f32x2* Eb = E + ((size_t)(r * 192) * 32 + g) * 64 + n;
        for (int k0 = 0; k0 < nprev; k0 += 8) { f32x2 ev[8][2];
#pragma unroll
            for (int k = 0; k < 8; ++k) { const int c = c0 + dc * min(k0 + k, nprev - 1);
                ev[k][0] = Eb[(size_t)c * 2048]; ev[k][1] = Eb[(size_t)c * 2048 + 32]; }
#pragma unroll
            for (int k = 0; k < 8; ++k) if (k0 + k < nprev) { carry[0] = cfma(A512[0], carry[0], ev[k][0]); carry[1] = cfma(A512[1], carry[1], ev[k][1]); } }
    }
    bf16* YF = (bf16*)(ws + WS_B1); bf16* YG = (bf16*)(ws + WS_B2);
    const f32x4 dsk = *(const f32x4*)(a.in[I_SD] + g * 16 + quad * 4);
    f32x16 zero16;
#pragma unroll
    for (int i = 0; i < 16; ++i) zero16[i] = 0.f;
    const int spA = 16 * ((n >> 2) & 1) + (n & 3) + 4 * (n >> 3), tokA = (r == 0) ? spA : 31 - spA;
    constexpr int PF = FULL ? 2 : 4;
    bf16x8 afr[PF]; u32x2 yfr[PF][2], uur[PF][2];
#pragma unroll
    for (int p = 0; p < PF; ++p) { const int tip = (r == 0) ? p : 15 - p; const int rowp = ci * 512 + tip * 32;
        afr[p] = *(const bf16x8*)(U + ((size_t)g * T + rowp + tokA) * 16 + hi * 8);
#pragma unroll
        for (int th = 0; th < 2; ++th) { yfr[p][th] = (u32x2){0u, 0u}; uur[p][th] = (u32x2){0u, 0u};
            if (FULL && r == 1) { const size_t idx = ((size_t)g * T + rowp + th * 16 + cch) * 16 + quad * 4; yfr[p][th] = ld_l2_u32x2(YF + idx); uur[p][th] = *(const u32x2*)(U + idx); } } }
#pragma unroll 1
    for (int tb = 0; tb < 16; tb += PF) {
#pragma unroll
      for (int us = 0; us < PF; ++us) {
        const int tt = tb + us;
        const int ti = (r == 0) ? tt : 15 - tt; const int row0 = ci * 512 + ti * 32;
        const bf16x8 af = afr[us]; const u32x2 yf0 = yfr[us][0], yf1 = yfr[us][1], uu0 = uur[us][0], uu1 = uur[us][1];
        if (tb + PF < 16) { const int rown = ci * 512 + ((r == 0) ? ti + PF : ti - PF) * 32;
            afr[us] = *(const bf16x8*)(U + ((size_t)g * T + rown + tokA) * 16 + hi * 8);
            if (FULL && r == 1) {
#pragma unroll
                for (int th = 0; th < 2; ++th) { const size_t idx = ((size_t)g * T + rown + th * 16 + cch) * 16 + quad * 4; yfr[us][th] = ld_l2_u32x2(YF + idx); uur[us][th] = *(const u32x2*)(U + idx); } } }
        const f32x16 d0 = MFMA32(af, bbf[0], zero16), d1 = MFMA32(af, bbf[1], zero16), d2 = MFMA32(af, bbf[2], zero16), d3 = MFMA32(af, bbf[3], zero16);
        if (FULL) {
            f32x2 s0 = carry[0], s1 = carry[1];
#pragma unroll
            for (int q = 0; q < 16; ++q) { f32x2 b0 = {d0[q], d1[q]}, b1 = {d2[q], d3[q]}; s0 = cfma(A2[0], s0, b0); s1 = cfma(A2[1], s1, b1); }
            { const f32x2 x0 = shfl32(s0), x1 = shfl32(s1); s0.x = hi ? x0.x : carry[0].x; s0.y = hi ? x0.y : carry[0].y; s1.x = hi ? x1.x : carry[1].x; s1.y = hi ? x1.y : carry[1].y; }
            asm volatile("" ::: "memory");
#pragma unroll
            for (int q = 0; q < 16; ++q) { const int sp = 16 * hi + q, tok = (r == 0) ? sp : 31 - sp;
                f32x2 b0 = {d0[q], d1[q]}, b1 = {d2[q], d3[q]}; s0 = cfma(A2[0], s0, b0); s1 = cfma(A2[1], s1, b1);
                *(LAS unsigned*)(wl + tok * S5_ROWB + n * 4) = pk2(s0.x, s0.y); *(LAS unsigned*)(wl + tok * S5_ROWB + (32 + n) * 4) = pk2(s1.x, s1.y); }
            asm volatile("" ::: "memory");
            carry[0] = shfl32(s0); carry[1] = shfl32(s1);
        } else {
            f32x2 s0 = {0.f, 0.f}, s1 = {0.f, 0.f};
#pragma unroll
            for (int q = 0; q < 16; ++q) { f32x2 b0 = {d0[q], d1[q]}, b1 = {d2[q], d3[q]}; s0 = cfma(A2[0], s0, b0); s1 = cfma(A2[1], s1, b1); }
            const f32x2 m0 = shfl32(cfma(P15[0], carry[0], s0)), m1 = shfl32(cfma(P15[1], carry[1], s1));
            f32x2 c0, c1; c0.x = hi ? m0.x : carry[0].x; c0.y = hi ? m0.y : carry[0].y; c1.x = hi ? m1.x : carry[1].x; c1.y = hi ? m1.y : carry[1].y;
            carry[0] = shfl32(cfma(P15[0], c0, s0)); carry[1] = shfl32(cfma(P15[1], c1, s1));
        }
        if (FULL) {
#pragma unroll
            for (int th = 0; th < 2; ++th) { f32x4 y = {0.f, 0.f, 0.f, 0.f};
#pragma unroll
                for (int kk = 0; kk < 4; ++kk) { const bf16x8 hf = *(const LAS bf16x8*)(wl + (th * 16 + cch) * S5_ROWB + kk * 64 + quad * 16); y = MFMA16(cmf[kk], hf, y); }
                const size_t idx = (size_t)(row0 + th * 16 + cch) * 512 + g * 16 + quad * 4, idg = ((size_t)g * T + row0 + th * 16 + cch) * 16 + quad * 4;
                if (r == 0) { u32x2 w; w.x = pk2(y[0], y[1]); w.y = pk2(y[2], y[3]); *(u32x2*)(YF + idg) = w; }
                else { const u32x2 yf = th ? yf1 : yf0, uu = th ? uu1 : uu0;
                    const float v0 = y[0] + bflo(yf.x) + dsk[0] * bflo(uu.x), v1 = y[1] + bfhi(yf.x) + dsk[1] * bfhi(uu.x);
                    const float v2 = y[2] + bflo(yf.y) + dsk[2] * bflo(uu.y), v3 = y[3] + bfhi(yf.y) + dsk[3] * bfhi(uu.y);
                    u32x2 w; w.x = pk2(gelu_tanh(v0), gelu_tanh(v1)); w.y = pk2(gelu_tanh(v2), gelu_tanh(v3)); *(u32x2*)(YG + idx) = w; } }
        }
        asm volatile("" ::: "memory");
        __builtin_amdgcn_sched_barrier(0);
      }
    }
    if (!FULL) { if (hi == 0) {
#pragma unroll
        for (int sh = 0; sh < 2; ++sh) E[((size_t)(r * 192 + ci) * 32 + g) * 64 + sh * 32 + n] = carry[sh]; } }
}
DI void s5_pass1(const Args& a, LAS unsigned char* lds, int wave, int lane) {
    LAS unsigned char* wl = lds + wave * (32 * S5_ROWB);
    const int gw = blockIdx.x * NWAVES + wave, NGW = gridDim.x * NWAVES;
    for (int task = gw; task < 2 * 158 * 32; task += NGW) { const int g = task & 31, cid = (task >> 5) % 158, r = (task >> 5) / 158;
        int ci; if (cid < 62) ci = (cid / 31) * 32 + cid % 31; else ci = 64 + ((cid - 62) / 3) * 4 + (cid - 62) % 3;
        if (r == 1) ci += 1;
        s5_sweep<false>(a, wl, ci, g, r, lane); }
}
DI void s5_pass3(const Args& a, LAS unsigned char* lds, int wave, int lane) {
    LAS unsigned char* wl = lds + wave * (32 * S5_ROWB);
    const int gw = blockIdx.x * NWAVES + wave, NGW = gridDim.x * NWAVES;
    for (int task = gw; task < 192 * 32; task += NGW) { const int g = task & 31, ci = task >> 5;
        s5_sweep<true>(a, wl, ci, g, 0, lane);
        asm volatile("s_waitcnt vmcnt(0)" ::: "memory");
        s5_sweep<true>(a, wl, ci, g, 1, lane); }
}

DI float log2_gamma(float logit) { return -log1pf(__expf(-logit)) * 1.4426950408889634f; }
constexpr int RA_ROWB = 272;
DI void ret_passA(const Args& a, LAS unsigned char* lds, int wave, int lane) {
    unsigned char* ws = a.ws; const int tid = threadIdx.x, hi = lane >> 5;
    const bf16* Kb = (const bf16*)(ws + WS_A + 2 * SEC); const bf16* Vt = (const bf16*)(ws + WS_A + 4 * SEC); bf16* ST = (bf16*)(ws + WS_B2);
    for (int u = blockIdx.x; u < 768 * 4; u += gridDim.x) { const int n = u >> 2, h = u & 3, tok0 = n * 128;
        const float lf2 = log2_gamma(a.in[I_DECAY][h]), lb2 = log2_gamma(a.in[I_DECAY][4 + h]);
        { const int j = tid >> 2, dq = tid & 3; const float wf = exp2f((float)(127 - j) * lf2), wb = exp2f((float)j * lb2);
#pragma unroll
            for (int q = 0; q < 4; ++q) { const int ks = dq * 2 + (q >> 1);
                const u32x4 kv = *(const u32x4*)(Kb + ((((size_t)(n * 4 + h) * 4 + (j >> 5)) * 8 + ks) * 64 + (q & 1) * 32 + swap23(j & 31)) * 8);
                const unsigned w4[4] = {kv.x, kv.y, kv.z, kv.w};
#pragma unroll
                for (int i = 0; i < 8; ++i) { const int d = dq * 32 + swap23(q * 8 + i); const float kx = (i & 1) ? bfhi(w4[i >> 1]) : bflo(w4[i >> 1]);
                    *(LAS unsigned short*)(lds + d * RA_ROWB + j * 2) = f2bf(kx * wf); *(LAS unsigned short*)(lds + 128 * RA_ROWB + d * RA_ROWB + j * 2) = f2bf(kx * wb); } } }
        __syncthreads();
        const int dir = wave >> 2, et = wave & 3, l31 = lane & 31;
        f32x16 acc[4];
#pragma unroll
        for (int dt = 0; dt < 4; ++dt)
#pragma unroll
            for (int i = 0; i < 16; ++i) acc[dt][i] = 0.f;
#pragma unroll
        for (int ks = 0; ks < 8; ++ks) { const bf16x8 vf = *(const bf16x8*)(Vt + (((((size_t)(n * 4 + h) * 4 + et) * 4 + (ks >> 1)) * 2 + (ks & 1)) * 64 + lane) * 8);
#pragma unroll
            for (int dt = 0; dt < 4; ++dt) { const bf16x8 kf = *(const LAS bf16x8*)(lds + dir * 128 * RA_ROWB + (dt * 32 + l31) * RA_ROWB + (ks * 16 + hi * 8) * 2); acc[dt] = MFMA32(kf, vf, acc[dt]); } }
        bf16* So = ST + ((size_t)(dir * 768 + n) * 4 + h) * 16384;
#pragma unroll
        for (int dt = 0; dt < 4; ++dt)
#pragma unroll
            for (int ah = 0; ah < 2; ++ah) { u32x4 w;
                w.x = pk2(acc[dt][8 * ah], acc[dt][8 * ah + 1]); w.y = pk2(acc[dt][8 * ah + 2], acc[dt][8 * ah + 3]); w.z = pk2(acc[dt][8 * ah + 4], acc[dt][8 * ah + 5]); w.w = pk2(acc[dt][8 * ah + 6], acc[dt][8 * ah + 7]);
                *(u32x4*)(So + (((size_t)(et * 8 + dt * 2 + ah) * 64) + hi * 32 + l31) * 8) = w; }
        __syncthreads();
    }
}
DI void ret_passB(const Args& a, bool dry = false) {
    unsigned char* ws = a.ws; bf16* ST = (bf16*)(ws + WS_B2);
    const int gt = blockIdx.x * NTHR + threadIdx.x, NGT = gridDim.x * NTHR;
    for (int item = gt; item < 34 * 2 * 4 * 2048; item += NGT) { const int v = item & 2047, h = (item >> 11) & 3, dir = (item >> 13) & 1, b = item >> 14;
        const int n0 = (b < 2) ? b * 128 : 256 + (b - 2) * 16, nc = (b < 2) ? 128 : 16;
        const float dec = exp2f(128.f * log2_gamma(a.in[I_DECAY][dir * 4 + h]));
        float s[8];
#pragma unroll
        for (int i = 0; i < 8; ++i) s[i] = 0.f;
        for (int q0 = 0; q0 < nc; q0 += 8) { u32x4 kv[8];
#pragma unroll
            for (int qq = 0; qq < 8; ++qq) { const int n = (dir == 0) ? n0 + q0 + qq : n0 + nc - 1 - q0 - qq; kv[qq] = *(const u32x4*)(ST + ((size_t)(dir * 768 + n) * 4 + h) * 16384 + v * 8); }
#pragma unroll
            for (int qq = 0; qq < 8; ++qq) { const int n = (dir == 0) ? n0 + q0 + qq : n0 + nc - 1 - q0 - qq;
                u32x4 o; o.x = pk2(s[0], s[1]); o.y = pk2(s[2], s[3]); o.z = pk2(s[4], s[5]); o.w = pk2(s[6], s[7]); if (dry) o = kv[qq]; *(u32x4*)(ST + ((size_t)(dir * 768 + n) * 4 + h) * 16384 + v * 8) = o;
                s[0] = dec * s[0] + bflo(kv[qq].x); s[1] = dec * s[1] + bfhi(kv[qq].x); s[2] = dec * s[2] + bflo(kv[qq].y); s[3] = dec * s[3] + bfhi(kv[qq].y);
                s[4] = dec * s[4] + bflo(kv[qq].z); s[5] = dec * s[5] + bfhi(kv[qq].z); s[6] = dec * s[6] + bflo(kv[qq].w); s[7] = dec * s[7] + bfhi(kv[qq].w); } }
    }
}
DI void ret_passC(const Args& a, int wave, int lane) {
    unsigned char* ws = a.ws; const int hi = lane >> 5, l31 = lane & 31;
    const bf16* Qb = (const bf16*)(ws + WS_A + 1 * SEC); const bf16* Kb = (const bf16*)(ws + WS_A + 2 * SEC); const bf16* Gb = (const bf16*)(ws + WS_A + 3 * SEC);
    const bf16* Vt = (const bf16*)(ws + WS_A + 4 * SEC); const bf16* ST = (const bf16*)(ws + WS_B2); bf16* MIX = (bf16*)(ws + WS_B1);
    for (int u = blockIdx.x; u < 768 * 2; u += gridDim.x) { const int n = u >> 1, h = (u & 1) * 2 + (wave >> 2), it = wave & 3, i = it * 32 + l31, tok = n * 128 + i;
        const float lf2 = log2_gamma(a.in[I_DECAY][h]), lb2 = log2_gamma(a.in[I_DECAY][4 + h]);
        bf16x8 qf[8];
#pragma unroll
        for (int ks = 0; ks < 8; ++ks) qf[ks] = *(const bf16x8*)(Qb + ((((size_t)(n * 4 + h) * 4 + it) * 8 + ks) * 64 + lane) * 8);
        const bf16* Sf = ST + ((size_t)(0 * 768 + n) * 4 + h) * 16384; const bf16* Sb = ST + ((size_t)(1 * 768 + n) * 4 + h) * 16384;
        f32x16 acc[4];
        const float qwf = exp2f((float)(i + 1) * lf2), qwb = exp2f((float)(128 - i) * lb2);
#pragma unroll
        for (int et = 0; et < 4; ++et) { f32x16 c1, c2;
#pragma unroll
            for (int q = 0; q < 16; ++q) { c1[q] = 0.f; c2[q] = 0.f; }
#pragma unroll
            for (int ks = 0; ks < 8; ++ks) { const bf16x8 a1 = *(const bf16x8*)(Sf + ((et * 8 + ks) * 64 + lane) * 8); c1 = MFMA32(a1, qf[ks], c1);
                const bf16x8 a2 = *(const bf16x8*)(Sb + ((et * 8 + ks) * 64 + lane) * 8); c2 = MFMA32(a2, qf[ks], c2); }
#pragma unroll
            for (int q = 0; q < 16; ++q) acc[et][q] = qwf * c1[q] + qwb * c2[q];
            __builtin_amdgcn_sched_barrier(0); }
#pragma unroll 1
        for (int jt = 0; jt < 4; ++jt) { f32x16 p;
#pragma unroll
            for (int q = 0; q < 16; ++q) p[q] = 0.f;
            bf16x8 ka8[8], va8[8];
#pragma unroll
            for (int ks = 0; ks < 8; ++ks) ka8[ks] = *(const bf16x8*)(Kb + ((((size_t)(n * 4 + h) * 4 + jt) * 8 + ks) * 64 + lane) * 8);
#pragma unroll
            for (int s = 0; s < 2; ++s)
#pragma unroll
                for (int et = 0; et < 4; ++et) va8[s * 4 + et] = *(const bf16x8*)(Vt + (((((size_t)(n * 4 + h) * 4 + et) * 4 + jt) * 2 + s) * 64 + lane) * 8);
            __builtin_amdgcn_sched_barrier(0);
#pragma unroll
            for (int ks = 0; ks < 8; ++ks) p = MFMA32(ka8[ks], qf[ks], p);
#pragma unroll
            for (int q = 0; q < 16; ++q) { const int dj = i - (jt * 32 + (q >> 3) * 16 + hi * 8 + (q & 7)); const float w = (dj >= 0) ? exp2f((float)dj * lf2) : exp2f((float)(-dj) * lb2); p[q] *= w; }
#pragma unroll
            for (int s = 0; s < 2; ++s) { const bf16x8 pb = pack8(p[8 * s], p[8 * s + 1], p[8 * s + 2], p[8 * s + 3], p[8 * s + 4], p[8 * s + 5], p[8 * s + 6], p[8 * s + 7]);
#pragma unroll
                for (int et = 0; et < 4; ++et) acc[et] = MFMA32(va8[s * 4 + et], pb, acc[et]);
                __builtin_amdgcn_sched_barrier(0); } }
        float ssq = 0.f;
#pragma unroll
        for (int et = 0; et < 4; ++et)
#pragma unroll
            for (int q = 0; q < 16; ++q) ssq += acc[et][q] * acc[et][q];
        ssq += __shfl_xor(ssq, 32);
        const float ri = rsqrtf(ssq * (1.f / 128.f) + EPS);
#pragma unroll
        for (int et = 0; et < 4; ++et)
#pragma unroll
            for (int ah = 0; ah < 2; ++ah) { const int e0 = et * 32 + 16 * ah + 8 * hi;
                const u32x4 gg = *(const u32x4*)(Gb + ((((size_t)(n * 4 + h) * 4 + it) * 8 + (et * 2 + ah)) * 64 + lane) * 8); const f32x4 nw0 = *(const f32x4*)(a.in[I_RNW] + h * 128 + e0), nw1 = *(const f32x4*)(a.in[I_RNW] + h * 128 + e0 + 4);
                const float g0 = bflo(gg.x), g1 = bfhi(gg.x), g2 = bflo(gg.y), g3 = bfhi(gg.y), g4 = bflo(gg.z), g5 = bfhi(gg.z), g6 = bflo(gg.w), g7 = bfhi(gg.w);
                u32x4 w;
                w.x = pk2(acc[et][8 * ah] * ri * nw0[0] * g0 * sigmoidf_(g0), acc[et][8 * ah + 1] * ri * nw0[1] * g1 * sigmoidf_(g1));
                w.y = pk2(acc[et][8 * ah + 2] * ri * nw0[2] * g2 * sigmoidf_(g2), acc[et][8 * ah + 3] * ri * nw0[3] * g3 * sigmoidf_(g3));
                w.z = pk2(acc[et][8 * ah + 4] * ri * nw1[0] * g4 * sigmoidf_(g4), acc[et][8 * ah + 5] * ri * nw1[1] * g5 * sigmoidf_(g5));
                w.w = pk2(acc[et][8 * ah + 6] * ri * nw1[2] * g6 * sigmoidf_(g6), acc[et][8 * ah + 7] * ri * nw1[3] * g7 * sigmoidf_(g7));
                *(u32x4*)(MIX + (size_t)tok * 1024 + 512 + h * 128 + e0) = w; }
    }
}

DI void xattn_phase(const Args& a, LAS unsigned char* lds, int wave, int lane) {
    unsigned char* ws = a.ws; const int hi = lane >> 5, l31 = lane & 31;
    const bf16* Qx = (const bf16*)(ws + WS_B1); const bf16* KM = (const bf16*)(ws + WS_KM); const bf16* VTM = (const bf16*)(ws + WS_VTM); bf16* O = (bf16*)(ws + WS_A);
    for (int u = blockIdx.x; u < 384 * 4; u += gridDim.x) { const int qb = u >> 2, h = u & 3, rowb = qb * 256, b = (rowb < TP) ? (rowb >> 14) : 2 + ((rowb - TP) >> 11);
        const int row = rowb + wave * 32 + l31;
        const char* Kg = (const char*)(KM + (size_t)(b * 4 + h) * 65536); const char* Vg = (const char*)(VTM + (size_t)(b * 4 + h) * 65536);
#pragma unroll
        for (int i = 0; i < 16; ++i) __builtin_amdgcn_global_load_lds((const unsigned*)(Kg + (wave * 16 + i) * 1024 + lane * 16), (LAS unsigned*)(lds + (wave * 16 + i) * 1024), 16, 0, 0);
        bf16x8 pbA[4][2], pbB[4][2]; float fA, inv_l;
        LAS unsigned char* l0 = lds + lane * 16; LAS unsigned char* l1 = lds + 65536 + lane * 16; asm volatile("" : "+v"(l1));
        {
            bf16x8 qf[16];
#pragma unroll
            for (int ks = 0; ks < 16; ++ks) qf[ks] = *(const bf16x8*)(Qx + (((((size_t)qb * 4 + h) * 8 + wave) * 16 + ks) * 64 + lane) * 8);
            asm volatile("s_waitcnt vmcnt(0)" ::: "memory"); __builtin_amdgcn_s_barrier(); asm volatile("" ::: "memory");
            __builtin_amdgcn_sched_barrier(0);
            float mA, lA;
            { f32x16 p[4];
#pragma unroll
                for (int jt = 0; jt < 4; ++jt)
#pragma unroll
                    for (int q = 0; q < 16; ++q) p[jt][q] = 0.f;
                { bf16x8 kc[4], kn[4];
#pragma unroll
                    for (int jt = 0; jt < 4; ++jt) kc[jt] = *(const LAS bf16x8*)(l0 + (jt * 16 + 0) * 1024);
#pragma unroll
                    for (int ks = 0; ks < 16; ++ks) {
                        if (ks < 15) {
#pragma unroll
                            for (int jt = 0; jt < 4; ++jt) kn[jt] = *(const LAS bf16x8*)(l0 + (jt * 16 + ks + 1) * 1024); }
                        __builtin_amdgcn_sched_barrier(0);
#pragma unroll
                        for (int jt = 0; jt < 4; ++jt) p[jt] = MFMA32(kc[jt], qf[ks], p[jt]);
                        __builtin_amdgcn_sched_barrier(0);
#pragma unroll
                        for (int jt = 0; jt < 4; ++jt) kc[jt] = kn[jt]; } }
                float mx = -3.0e38f;
#pragma unroll
                for (int jt = 0; jt < 4; ++jt)
#pragma unroll
                    for (int q = 0; q < 16; ++q) mx = fmaxf(mx, p[jt][q]);
                mA = fmaxf(mx, __shfl_xor(mx, 32));
                float sum = 0.f;
#pragma unroll
                for (int jt = 0; jt < 4; ++jt)
#pragma unroll
                    for (int q = 0; q < 16; ++q) { const float e = __builtin_amdgcn_exp2f((p[jt][q] - mA) * 1.4426950408889634f); p[jt][q] = e; sum += e; if ((q & 7) == 7) __builtin_amdgcn_sched_barrier(0); }
                lA = sum + __shfl_xor(sum, 32);
#pragma unroll
                for (int jt = 0; jt < 4; ++jt)
#pragma unroll
                    for (int s2 = 0; s2 < 2; ++s2) pbA[jt][s2] = pack8(p[jt][8 * s2], p[jt][8 * s2 + 1], p[jt][8 * s2 + 2], p[jt][8 * s2 + 3], p[jt][8 * s2 + 4], p[jt][8 * s2 + 5], p[jt][8 * s2 + 6], p[jt][8 * s2 + 7]); }
            __builtin_amdgcn_sched_barrier(0);
            { f32x16 p[4];
#pragma unroll
                for (int jt = 0; jt < 4; ++jt)
#pragma unroll
                    for (int q = 0; q < 16; ++q) p[jt][q] = 0.f;
                { bf16x8 kc[4], kn[4];
#pragma unroll
                    for (int jt = 0; jt < 4; ++jt) kc[jt] = *(const LAS bf16x8*)(l1 + (jt * 16 + 0) * 1024);
#pragma unroll
                    for (int ks = 0; ks < 16; ++ks) {
                        if (ks < 15) {
#pragma unroll
                            for (int jt = 0; jt < 4; ++jt) kn[jt] = *(const LAS bf16x8*)(l1 + (jt * 16 + ks + 1) * 1024); }
                        __builtin_amdgcn_sched_barrier(0);
#pragma unroll
                        for (int jt = 0; jt < 4; ++jt) p[jt] = MFMA32(kc[jt], qf[ks], p[jt]);
                        __builtin_amdgcn_sched_barrier(0);
#pragma unroll
                        for (int jt = 0; jt < 4; ++jt) kc[jt] = kn[jt]; } }
                asm volatile("s_waitcnt lgkmcnt(0)" ::: "memory"); __builtin_amdgcn_s_barrier(); asm volatile("" ::: "memory");
#pragma unroll
                for (int i = 0; i < 16; ++i) __builtin_amdgcn_global_load_lds((const unsigned*)(Vg + (wave * 16 + i) * 1024 + lane * 16), (LAS unsigned*)(lds + (wave * 16 + i) * 1024), 16, 0, 0);
                float mx = -3.0e38f;
#pragma unroll
                for (int jt = 0; jt < 4; ++jt)
#pragma unroll
                    for (int q = 0; q < 16; ++q) mx = fmaxf(mx, p[jt][q]);
                mx = fmaxf(mx, __shfl_xor(mx, 32));
                const float m = fmaxf(mA, mx);
                float sum = 0.f;
#pragma unroll
                for (int jt = 0; jt < 4; ++jt)
#pragma unroll
                    for (int q = 0; q < 16; ++q) { const float e = __builtin_amdgcn_exp2f((p[jt][q] - m) * 1.4426950408889634f); p[jt][q] = e; sum += e; if ((q & 7) == 7) __builtin_amdgcn_sched_barrier(0); }
                sum += __shfl_xor(sum, 32);
                fA = exp2f((mA - m) * 1.4426950408889634f); inv_l = 1.f / (fA * lA + sum);
#pragma unroll
                for (int jt = 0; jt < 4; ++jt)
#pragma unroll
                    for (int s2 = 0; s2 < 2; ++s2) pbB[jt][s2] = pack8(p[jt][8 * s2], p[jt][8 * s2 + 1], p[jt][8 * s2 + 2], p[jt][8 * s2 + 3], p[jt][8 * s2 + 4], p[jt][8 * s2 + 5], p[jt][8 * s2 + 6], p[jt][8 * s2 + 7]); }
        }
        asm volatile("s_waitcnt vmcnt(0) lgkmcnt(0)" ::: "memory"); __builtin_amdgcn_s_barrier(); asm volatile("" ::: "memory");
#pragma unroll 1
        for (int eh = 0; eh < 2; ++eh) { f32x16 acc[4]; LAS unsigned char* lv = eh ? l1 : l0;
#pragma unroll
            for (int et = 0; et < 4; ++et)
#pragma unroll
                for (int q = 0; q < 16; ++q) acc[et][q] = 0.f;
            { bf16x8 vc[4], vn[4];
#pragma unroll
                for (int et = 0; et < 4; ++et) vc[et] = *(const LAS bf16x8*)(lv + ((et * 8 + 0) * 2 + 0) * 1024);
#pragma unroll
                for (int st = 0; st < 8; ++st) { const int jt = st >> 1, s2 = st & 1;
                    if (st < 7) { const int jn = (st + 1) >> 1, sn = (st + 1) & 1;
#pragma unroll
                        for (int et = 0; et < 4; ++et) vn[et] = *(const LAS bf16x8*)(lv + ((et * 8 + jn) * 2 + sn) * 1024); }
                    __builtin_amdgcn_sched_barrier(0);
#pragma unroll
                    for (int et = 0; et < 4; ++et) acc[et] = MFMA32(vc[et], pbA[jt][s2], acc[et]);
                    __builtin_amdgcn_sched_barrier(0);
#pragma unroll
                    for (int et = 0; et < 4; ++et) vc[et] = vn[et]; } }
#pragma unroll
            for (int et = 0; et < 4; ++et)
#pragma unroll
                for (int q = 0; q < 16; ++q) acc[et][q] *= fA;
            { bf16x8 vc[4], vn[4];
#pragma unroll
                for (int et = 0; et < 4; ++et) vc[et] = *(const LAS bf16x8*)(lv + ((et * 8 + 4 + 0) * 2 + 0) * 1024);
#pragma unroll
                for (int st = 0; st < 8; ++st) { const int jt = st >> 1, s2 = st & 1;
                    if (st < 7) { const int jn = (st + 1) >> 1, sn = (st + 1) & 1;
#pragma unroll
                        for (int et = 0; et < 4; ++et) vn[et] = *(const LAS bf16x8*)(lv + ((et * 8 + 4 + jn) * 2 + sn) * 1024); }
                    __builtin_amdgcn_sched_barrier(0);
#pragma unroll
                    for (int et = 0; et < 4; ++et) acc[et] = MFMA32(vc[et], pbB[jt][s2], acc[et]);
                    __builtin_amdgcn_sched_barrier(0);
#pragma unroll
                    for (int et = 0; et < 4; ++et) vc[et] = vn[et]; } }
#pragma unroll
            for (int et = 0; et < 4; ++et)
#pragma unroll
                for (int ah = 0; ah < 2; ++ah) { const int e0 = (eh * 4 + et) * 32 + 16 * ah + 8 * hi;
                    u32x4 w; w.x = pk2(acc[et][8 * ah] * inv_l, acc[et][8 * ah + 1] * inv_l); w.y = pk2(acc[et][8 * ah + 2] * inv_l, acc[et][8 * ah + 3] * inv_l);
                    w.z = pk2(acc[et][8 * ah + 4] * inv_l, acc[et][8 * ah + 5] * inv_l); w.w = pk2(acc[et][8 * ah + 6] * inv_l, acc[et][8 * ah + 7] * inv_l);
                    *(u32x4*)(O + (size_t)row * 1024 + h * 256 + e0) = w; } }
        asm volatile("s_waitcnt lgkmcnt(0)" ::: "memory"); __builtin_amdgcn_s_barrier(); asm volatile("" ::: "memory");
    }
}

DI void final_norm(const Args& a, int wave, int lane_unused, bool dry = false) {
    const int lane = (int)__builtin_amdgcn_mbcnt_hi(~0u, __builtin_amdgcn_mbcnt_lo(~0u, 0u)); (void)lane_unused;
    const int gw = blockIdx.x * NWAVES + wave, NGW = gridDim.x * NWAVES;
    const bf16* X3 = (const bf16*)(a.ws + WS_B1);
    const f32x4* fw = (const f32x4*)a.in[I_FINW] + 2 * lane;
    f32x4 w[2][2];
#pragma unroll
    for (int j = 0; j < 2; ++j) { w[j][0] = fw[128 * j]; w[j][1] = fw[128 * j + 1]; }
    for (int m0 = gw * 4; m0 < T; m0 += NGW * 4) { u32x4 x[4][2]; float sq[4];
#pragma unroll
        for (int r = 0; r < 4; ++r) { const u32x4* xr = (const u32x4*)(X3 + (size_t)(m0 + r) * 1024) + lane; x[r][0] = xr[0]; x[r][1] = xr[64]; }
#pragma unroll
        for (int r = 0; r < 4; ++r) { sq[r] = 0.f;
#pragma unroll
            for (int j = 0; j < 2; ++j) { const unsigned w4[4] = {x[r][j].x, x[r][j].y, x[r][j].z, x[r][j].w};
#pragma unroll
                for (int e = 0; e < 4; ++e) { const float lo = bflo(w4[e]), hi2 = bfhi(w4[e]); sq[r] += lo * lo + hi2 * hi2; } } }
#pragma unroll
        for (int o = 1; o < 64; o <<= 1) {
#pragma unroll
            for (int r = 0; r < 4; ++r) sq[r] += __shfl_xor(sq[r], o); }
#pragma unroll
        for (int r = 0; r < 4; ++r) { const float ri = rsqrtf(sq[r] * (1.f / 1024.f) + EPS); f32x4* orow = (f32x4*)(a.out + (size_t)(m0 + r) * 1024) + 2 * lane;
#pragma unroll
            for (int j = 0; j < 2; ++j) { f32x4 o0, o1;
                o0[0] = bflo(x[r][j].x) * ri * w[j][0][0]; o0[1] = bfhi(x[r][j].x) * ri * w[j][0][1]; o0[2] = bflo(x[r][j].y) * ri * w[j][0][2]; o0[3] = bfhi(x[r][j].y) * ri * w[j][0][3];
                o1[0] = bflo(x[r][j].z) * ri * w[j][1][0]; o1[1] = bfhi(x[r][j].z) * ri * w[j][1][1]; o1[2] = bflo(x[r][j].w) * ri * w[j][1][2]; o1[3] = bfhi(x[r][j].w) * ri * w[j][1][3];
                orow[128 * j] = o0; orow[128 * j + 1] = o1; } } }
    (void)dry;
}

#define XB_TMO      128
#define XB_XCNT(j)  (256  + 64 * (j))
#define XB_XSUB(j)  (1280 + 64 * (j))
#define XB_XGEN(j)  (2304 + 64 * (j))
#define XB_TOP      3328
#define XB_TOPGEN   3392
#define XCD_BAR_WORDS 3456
#define XB_SPIN_CAP (1u << 18)

__device__ __forceinline__ unsigned xb_ld(unsigned* p)              { return __hip_atomic_load(p, __ATOMIC_RELAXED, __HIP_MEMORY_SCOPE_AGENT); }
__device__ __forceinline__ unsigned xb_add(unsigned* p, unsigned v) { return __hip_atomic_fetch_add(p, v, __ATOMIC_RELAXED, __HIP_MEMORY_SCOPE_AGENT); }
__device__ __forceinline__ unsigned xb_xcc_id() { return (unsigned)__builtin_amdgcn_s_getreg((3 << 11) | 20) & 0xFu; }
#define XB_SPIN(cond, bar) do { unsigned _sp = 0; while (cond) { __builtin_amdgcn_s_sleep(1); \
    if ((++_sp & 255u) == 0u) { if (xb_ld(&(bar)[XB_TMO])) break; if (_sp > XB_SPIN_CAP) { atomicAdd(&(bar)[XB_TMO], 1u); break; } } } } while (0)

struct XcdBarrier {
    unsigned* bar; unsigned x;
    volatile LAS unsigned* st;
};

__device__ __forceinline__ XcdBarrier xcd_barrier_post(unsigned* bar, volatile LAS unsigned* st) {
    XcdBarrier b; b.bar = bar; b.x = xb_xcc_id(); b.st = st;
    if (threadIdx.x == 0) (void)xb_add(&bar[XB_XCNT(b.x)], 1u);
    return b;
}
__device__ __forceinline__ void xcd_barrier_complete(unsigned* bar, unsigned x, unsigned& nloc, unsigned& nx) {
    const unsigned G = gridDim.x * gridDim.y * gridDim.z;
    unsigned sum, cnt, mine, sp = 0u;
    for (;;) {
        sum = 0u; cnt = 0u; mine = 0u;
#pragma unroll
        for (unsigned j = 0; j < 16; ++j) { const unsigned c = xb_ld(&bar[XB_XCNT(j)]); sum += c; cnt += (c > 0u) ? 1u : 0u; mine = (j == x) ? c : mine; }
        if (sum == G) break;
        __builtin_amdgcn_s_sleep(1);
        if ((++sp & 255u) == 0u) { if (xb_ld(&bar[XB_TMO])) break; if (sp > XB_SPIN_CAP) { atomicAdd(&bar[XB_TMO], 1u); break; } }
    }
    nloc = mine > 0u ? mine : 1u; nx = cnt > 0u ? cnt : 1u;
}

__device__ __forceinline__ void xcd_barrier(const XcdBarrier& b) {
    asm volatile("s_waitcnt vmcnt(0)" ::: "memory");
    __syncthreads();
    if (threadIdx.x == 0) {
        unsigned* bar = b.bar;
        __builtin_amdgcn_s_waitcnt(0);
        unsigned nloc = b.st[0], nx = b.st[1];
        if (nloc == 0u) { xcd_barrier_complete(bar, b.x, nloc, nx); b.st[0] = nloc; b.st[1] = nx; }
        const unsigned old = xb_add(&bar[XB_XSUB(b.x)], 1u);
        const unsigned gen = old / nloc;
        if (old + 1u == (gen + 1u) * nloc) {
            __builtin_amdgcn_fence(__ATOMIC_RELEASE, "agent");
            asm volatile("s_waitcnt vmcnt(0)" ::: "memory");
            const unsigned og = xb_add(&bar[XB_TOP], 1u);
            const unsigned tg = og / nx;
            if (og + 1u == (tg + 1u) * nx) xb_add(&bar[XB_TOPGEN], 1u);
            else XB_SPIN(xb_ld(&bar[XB_TOPGEN]) == tg, bar);
            __builtin_amdgcn_fence(__ATOMIC_ACQUIRE, "agent");
            xb_add(&bar[XB_XGEN(b.x)], 1u);
            asm volatile("s_waitcnt vmcnt(0)" ::: "memory");
        } else {
            XB_SPIN(xb_ld(&bar[XB_XGEN(b.x)]) == gen, bar);
            __builtin_amdgcn_fence(__ATOMIC_ACQUIRE, "agent");
            asm volatile("s_waitcnt vmcnt(0)" ::: "memory");
        }
    }
    __syncthreads();
}

constexpr int NPHASE = 15;
#ifndef MK_N_LAUNCHES
#define MK_N_LAUNCHES 1
#endif
__global__ void __launch_bounds__(NTHR) mk_fwd(Args a) {
    extern __shared__ __attribute__((aligned(16))) unsigned char lds_raw[];
    LAS unsigned char* lds = (LAS unsigned char*)lds_raw;
    cg::grid_group grid = cg::this_grid();
    const int tid = threadIdx.x, lane = tid & 63, wave = __builtin_amdgcn_readfirstlane(tid >> 6);
    unsigned char* ws = a.ws; const int lo = a.ph_lo, hi = a.ph_hi; const int G = gridDim.x, bx = blockIdx.x;
#ifndef PH_MASK
#define PH_MASK 0x7fff
#endif
#ifndef PH_REP_MASK
#define PH_REP_MASK 0
#endif
#define NREP(k) (1 + ((PH_REP_MASK >> (k)) & 1))
#define IN(k) (((PH_MASK >> (k)) & 1) && lo <= (k) && (k) < hi)
#ifndef SYNC_REP
#define SYNC_REP 1
#endif
#define SEAM(k) do { if (IN(k) && IN((k) + 1)) xcd_barrier(bar); } while (0)
    if (lo < 0) grid.sync();
    volatile LAS unsigned* bar_st = (volatile LAS unsigned*)(lds + (LDS_BYTES - 64));
    if (tid < 2) bar_st[tid] = 0u;
    __syncthreads();
    const XcdBarrier bar = xcd_barrier_post((unsigned*)(ws + WS_BAR), bar_st);
    bf16* B1 = (bf16*)(ws + WS_B1); bf16* B2 = (bf16*)(ws + WS_B2); bf16* AU = (bf16*)(ws + WS_A);
    float* ss2 = (float*)(ws + WS_SS2); float* ss3 = (float*)(ws + WS_SS3);
    if (IN(0)) for (int rep_ = 0; rep_ < NREP(0); ++rep_) { p0_prologue(a, lds, wave, lane); } SEAM(0);
    if (IN(1)) for (int rep_ = 0; rep_ < NREP(1); ++rep_) {
        { pg8::Gemm g{B1, (const bf16*)(ws + WS_WIN), T, 2048, 1024}; pg8::StaticOrder S; S.init(T, 2048, G, bx); EpiZ E{AU, (const float*)(ws + WS_RT)};
          pg8::gemm_phase<EpiZ, pg8::StaticOrder, true, true>(lds, g, S, E); }
        { pg8::Gemm g{(const bf16*)(ws + WS_WIN) + (size_t)2048 * 1024, B1, 512, T, 1024}; pg8::StaticOrder S; S.init(512, T, G, bx); EpiFrag<0> E{(bf16*)(ws + WS_A + 4 * SEC)};
          pg8::gemm_phase<EpiFrag<0>, pg8::StaticOrder, true, true>(lds, g, S, E); }
        { pg8::Gemm g{(const bf16*)(ws + WS_MN), (const bf16*)(ws + WS_WKM), NMR, 1024, 1024}; pg8::StaticOrder S; S.init(NMR, 1024, G, bx); EpiFrag<1> E{(bf16*)(ws + WS_KM)};
          pg8::gemm_phase<EpiFrag<1>, pg8::StaticOrder, true, true>(lds, g, S, E); }
        { pg8::Gemm g{(const bf16*)(ws + WS_WVM), (const bf16*)(ws + WS_MN), 1024, NMR, 1024}; pg8::StaticOrder S; S.init(1024, NMR, G, bx); EpiFrag<2> E{(bf16*)(ws + WS_VTM)};
          pg8::gemm_phase<EpiFrag<2>, pg8::StaticOrder, true, true>(lds, g, S, E); }
    } SEAM(1);
    if (IN(2)) for (int rep_ = 0; rep_ < NREP(2); ++rep_) { s5_pass1(a, lds, wave, lane); } SEAM(2);
    if (IN(3)) for (int rep_ = 0; rep_ < NREP(3); ++rep_) { s5_pass3(a, lds, wave, lane); } SEAM(3);
    if (IN(4)) for (int rep_ = 0; rep_ < NREP(4); ++rep_) { pg8::Gemm g{B2, (const bf16*)(ws + WS_WGLU), T, 512, 512}; pg8::StaticOrder S; S.init(T, 512, G, bx); EpiGlu E{B1, B2, a.in[I_BGLU]};
        pg8::gemm_phase<EpiGlu, pg8::StaticOrder, true, true>(lds, g, S, E); } SEAM(4);
    if (IN(5)) for (int rep_ = 0; rep_ < NREP(5); ++rep_) { ret_passA(a, lds, wave, lane); } SEAM(5);
    if (IN(6)) for (int rep_ = 0; rep_ < NREP(6); ++rep_) { ret_passB(a, rep_ + 1 < NREP(6)); } SEAM(6);
    if (IN(7)) for (int rep_ = 0; rep_ < NREP(7); ++rep_) { ret_passC(a, wave, lane); } SEAM(7);
    if (IN(8)) for (int rep_ = 0; rep_ < NREP(8); ++rep_) { pg8::Gemm g{B1, (const bf16*)(ws + WS_WOUT), T, 1024, 1024}; pg8::StaticOrder S; S.init(T, 1024, G, bx); EpiRes<false> E{a.in[I_XP], a.in[I_XS], nullptr, B2, ss2};
        pg8::gemm_phase<EpiRes<false>, pg8::StaticOrder, true, true>(lds, g, S, E); } SEAM(8);
    if (IN(9)) for (int rep_ = 0; rep_ < NREP(9); ++rep_) { pg8::Gemm g{B2, (const bf16*)(ws + WS_WCQ), T, 1024, 1024}; pg8::StaticOrder S; S.init(T, 1024, G, bx); EpiScale E{B1, ss2};
        pg8::gemm_phase<EpiScale, pg8::StaticOrder, true, true>(lds, g, S, E); } SEAM(9);
    if (IN(10)) for (int rep_ = 0; rep_ < NREP(10); ++rep_) { xattn_phase(a, lds, wave, lane); } SEAM(10);
    if (IN(11)) for (int rep_ = 0; rep_ < NREP(11); ++rep_) { pg8::Gemm g{AU, (const bf16*)(ws + WS_WCO), T, 1024, 1024}; pg8::StaticOrder S; S.init(T, 1024, G, bx); EpiRes<true> E{nullptr, nullptr, B2, B2, ss3};
        pg8::gemm_phase<EpiRes<true>, pg8::StaticOrder, true, true>(lds, g, S, E); } SEAM(11);
    if (IN(12)) for (int rep_ = 0; rep_ < NREP(12); ++rep_) { pg8::Gemm g{B2, (const bf16*)(ws + WS_WGU), T, 2 * DFF, 1024}; pg8::StaticOrder S; S.init(T, 2 * DFF, G, bx); EpiSwiglu E{AU, ss3};
        pg8::gemm_phase<EpiSwiglu, pg8::StaticOrder, true, true>(lds, g, S, E); } SEAM(12);
    if (IN(13)) for (int rep_ = 0; rep_ < NREP(13); ++rep_) { pg8::Gemm g{AU, (const bf16*)(ws + WS_WDN), T, 1024, DFF}; pg8::StaticOrder S; S.init(T, 1024, G, bx); EpiRes<true> E{nullptr, nullptr, B2, B1, nullptr};
        pg8::gemm_phase<EpiRes<true>, pg8::StaticOrder, true, true>(lds, g, S, E); } SEAM(13);
    if (IN(14)) for (int rep_ = 0; rep_ < NREP(14); ++rep_) { final_norm(a, wave, lane, rep_ + 1 < NREP(14)); }
#undef IN
#undef SEAM
}

extern "C" void kernel_launch(void* const* d_in, const int* in_sizes, int n_in, void* d_out, int out_size, void* d_ws, size_t ws_size, hipStream_t stream) {
    static int grid = 0;
    if (grid == 0) {
        if (n_in != 29 || out_size != T * DM || ws_size < WS_END) { fprintf(stderr, "kernel_launch: unexpected shapes: n_in %d out %d ws %zu (need %zu)\n", n_in, out_size, ws_size, (size_t)WS_END); grid = -1; return; }
        int dev = 0, cus = 0;
        if (hipGetDevice(&dev) != hipSuccess || hipDeviceGetAttribute(&cus, hipDeviceAttributeMultiprocessorCount, dev) != hipSuccess) { grid = -1; return; }
        if (hipFuncSetAttribute((const void*)mk_fwd, hipFuncAttributeMaxDynamicSharedMemorySize, LDS_BYTES) != hipSuccess) { fprintf(stderr, "kernel_launch: hipFuncSetAttribute failed\n"); grid = -1; return; }
        int per_cu = 0;
        if (hipOccupancyMaxActiveBlocksPerMultiprocessor(&per_cu, (const void*)mk_fwd, NTHR, LDS_BYTES) != hipSuccess || per_cu < 1) { fprintf(stderr, "kernel_launch: occupancy query says %d\n", per_cu); per_cu = 1; }
        (void)hipGetLastError();
        grid = cus;
    }
    if (grid < 0) return;
    Args a{};
    for (int i = 0; i < 29; ++i) a.in[i] = (const float*)d_in[i];
    a.out = (float*)d_out; a.ws = (unsigned char*)d_ws;
#if MK_N_LAUNCHES == 1
    if (hipMemsetAsync((char*)d_ws + WS_BAR, 0, 16384, stream) != hipSuccess) { fprintf(stderr, "kernel_launch: hipMemsetAsync failed\n"); return; }
    a.ph_lo = 0; a.ph_hi = NPHASE;
    void* args[] = {&a};
    hipError_t e = hipLaunchCooperativeKernel((const void*)mk_fwd, dim3(grid), dim3(NTHR), args, LDS_BYTES, stream);
    if (e != hipSuccess) fprintf(stderr, "cooperative launch failed: %s (grid %d)\n", hipGetErrorString(e), grid);
#else
    for (int p = 0; p < 15; ++p) { a.ph_lo = p; a.ph_hi = p + 1; hipLaunchKernelGGL(mk_fwd, dim3(grid), dim3(NTHR), LDS_BYTES, stream, a); }
#endif
}
```
